# Optimizing an MI355X kernel written in HIP

```python
import math
import jax, jax.numpy as jnp
from jax import lax
import numpy as np

D_MODEL = 1024
BATCH = 16
SEQ = 2048
DEPTH = 2

M_HEADS = 4
M_QK = 64
M_V = 128
M_WIDTH = M_HEADS * M_V
CONV_W = 4
A_HEADS = 8
A_HEAD_DIM = 64
A_WIDTH = A_HEADS * A_HEAD_DIM
Q_RANK = 256
KV_RANK = 128
IDX_HEADS = 8
IDX_DIM = 64
TOPK_MAX = 256
R_HEADS = 4
R_QK = 128
R_V = 128
R_WIDTH = R_HEADS * R_V
CHUNK = 128
Q_BLOCK = 128
N_BUCKETS = 32
MAX_DISTANCE = 128
ROPE_BASE = 10000.0
EPS = 1e-6
D_FF = -(((-8 * D_MODEL) // 3) // 256) * 256
IN_SPLITS = (M_HEADS * M_QK, M_HEADS * M_QK, M_WIDTH, M_HEADS, M_HEADS, M_WIDTH,
             Q_RANK, IDX_DIM, IDX_HEADS, KV_RANK,
             R_HEADS * R_QK, R_HEADS * R_QK, R_WIDTH, R_WIDTH,
             D_MODEL, D_MODEL, D_MODEL)
D_IN = sum(IN_SPLITS)

kernel_name = 'hybrid_mlstm_dsa_retention_block'


def rms_norm(x, g):
    xf = x.astype(jnp.float32)
    y = xf * lax.rsqrt(jnp.mean(xf * xf, axis=-1, keepdims=True) + EPS)
    return (y * g.astype(jnp.float32)).astype(x.dtype)


def layer_norm(x, g):
    xf = x.astype(jnp.float32)
    mu = jnp.mean(xf, axis=-1, keepdims=True)
    xc = xf - mu
    y = xc * lax.rsqrt(jnp.mean(xc * xc, axis=-1, keepdims=True) + EPS)
    return (y * g.astype(jnp.float32)).astype(x.dtype)


def head_layer_norm(x, g):
    return layer_norm(x, g.reshape(x.shape[-2:]))


def causal_conv(x, w):
    k_w, c = w.shape
    return lax.conv_general_dilated(x, w[:, None, :].astype(x.dtype), window_strides=(1,),
                                    padding=[(k_w - 1, 0)],
                                    dimension_numbers=('NWC', 'WIO', 'NWC'),
                                    feature_group_count=c)


def rotary(x, pos):
    half = x.shape[-1] // 2
    freqs = ROPE_BASE ** (-jnp.linspace(0.0, 1.0, half, dtype=jnp.float32))
    ang = pos[:, None] * freqs[None, :]
    cos = jnp.cos(ang)[:, None, :]
    sin = jnp.sin(ang)[:, None, :]
    xf = x.astype(jnp.float32)
    x1, x2 = xf[..., :half], xf[..., half:]
    return jnp.concatenate([x1 * cos - x2 * sin, x1 * sin + x2 * cos], axis=-1).astype(x.dtype)


def t5_bucket(dist):
    max_exact = N_BUCKETS // 2
    d_f = jnp.maximum(dist, 1).astype(jnp.float32)
    large = max_exact + (jnp.log(d_f / max_exact) / math.log(MAX_DISTANCE / max_exact)
                         * (N_BUCKETS - max_exact)).astype(jnp.int32)
    large = jnp.minimum(large, N_BUCKETS - 1)
    return jnp.where(dist < max_exact, dist, large)


def to_chunks(x):
    b, s, h = x.shape[:3]
    rest = x.shape[3:]
    x = x.reshape((b, s // CHUNK, CHUNK, h) + rest)
    return jnp.transpose(x, (1, 0, 3, 2) + tuple(range(4, x.ndim)))


def from_chunks(x):
    n, b, h, l, d = x.shape
    return jnp.transpose(x, (1, 0, 3, 2, 4)).reshape(b, n * l, h, d)


def mlstm(q, k, v, i_pre, f_pre):
    dtype = v.dtype
    b, s, h, dk = q.shape
    dv = v.shape[-1]
    f32 = jnp.float32
    q = q.astype(f32) * dk ** -0.5
    k = k.astype(f32)
    v = v.astype(f32)
    log_f = jax.nn.log_sigmoid(f_pre.astype(f32))
    log_i = i_pre.astype(f32)
    causal = jnp.tril(jnp.ones((CHUNK, CHUNK), dtype=bool))

    def step(carry, inp):
        c_st, n_st, m_st = carry
        qc, kc, vc, lf, li = inp
        bcum = jnp.cumsum(lf, axis=-1)
        d_log = bcum[..., :, None] - bcum[..., None, :] + li[..., None, :]
        d_log = jnp.where(causal, d_log, -jnp.inf)
        inter = bcum + m_st[..., None]
        m_row = jnp.maximum(inter, jnp.max(d_log, axis=-1))
        w_intra = jnp.exp(d_log - m_row[..., None])
        w_inter = jnp.exp(inter - m_row)
        sc = jnp.einsum('bhld,bhrd->bhlr', qc, kc) * w_intra
        num = (jnp.einsum('bhlr,bhrv->bhlv', sc, vc)
               + w_inter[..., None] * jnp.einsum('bhld,bhdv->bhlv', qc, c_st))
        den = jnp.sum(sc, axis=-1) + w_inter * jnp.einsum('bhld,bhd->bhl', qc, n_st)
        out = num / jnp.maximum(jnp.abs(den), jnp.exp(-m_row))[..., None]
        b_last = bcum[..., -1]
        g_log = b_last[..., None] - bcum + li
        m_new = jnp.maximum(b_last + m_st, jnp.max(g_log, axis=-1))
        wk = jnp.exp(g_log - m_new[..., None])
        decay = jnp.exp(b_last + m_st - m_new)
        c_new = decay[..., None, None] * c_st + jnp.einsum('bhl,bhld,bhlv->bhdv', wk, kc, vc)
        n_new = decay[..., None] * n_st + jnp.einsum('bhl,bhld->bhd', wk, kc)
        return (c_new, n_new, m_new), out

    init = (jnp.zeros((b, h, dk, dv), f32), jnp.zeros((b, h, dk), f32), jnp.zeros((b, h), f32))
    _, out = lax.scan(step, init, (to_chunks(q), to_chunks(k), to_chunks(v),
                                   to_chunks(log_f), to_chunks(log_i)))
    return from_chunks(out).astype(dtype)


def retention(q, k, v):
    dtype = v.dtype
    b, s, h, dk = q.shape
    dv = v.shape[-1]
    f32 = jnp.float32
    q = q.astype(f32)
    k = k.astype(f32) * dk ** -0.5
    v = v.astype(f32)
    log_gamma = jnp.log1p(-jnp.exp2(-5.0 - jnp.arange(h, dtype=f32)))
    pos = jnp.arange(CHUNK, dtype=f32)
    diff = pos[:, None] - pos[None, :]
    intra = jnp.where(diff >= 0, jnp.exp(jnp.maximum(diff, 0.0)[None] * log_gamma[:, None, None]), 0.0)
    q_decay = jnp.exp((pos[None, :] + 1.0) * log_gamma[:, None])
    k_decay = jnp.exp((CHUNK - 1.0 - pos[None, :]) * log_gamma[:, None])
    chunk_decay = jnp.exp(CHUNK * log_gamma)

    def step(state, inp):
        qc, kc, vc = inp
        sc = jnp.einsum('bhld,bhrd->bhlr', qc, kc) * intra
        out = (jnp.einsum('bhlr,bhrv->bhlv', sc, vc)
               + q_decay[..., None] * jnp.einsum('bhld,bhdv->bhlv', qc, state))
        state = chunk_decay[:, None, None] * state + jnp.einsum('bhrd,hr,bhrv->bhdv', kc, k_decay, vc)
        return state, out

    _, out = lax.scan(step, jnp.zeros((b, h, dk, dv), f32), (to_chunks(q), to_chunks(k), to_chunks(v)))
    return from_chunks(out).astype(dtype)


def dsa_attention(q_lat, c_kv, q_idx, k_idx, w_idx, rel_bias):
    b, s = c_kv.shape[:2]
    top_k = min(TOPK_MAX, s // 4)
    key_pos = jnp.arange(s, dtype=jnp.int32)
    f32 = jnp.float32

    def block(start):
        qb = lax.dynamic_slice_in_dim(q_lat, start, Q_BLOCK, axis=1)
        qib = lax.dynamic_slice_in_dim(q_idx, start, Q_BLOCK, axis=1)
        wb = lax.dynamic_slice_in_dim(w_idx, start, Q_BLOCK, axis=1)
        q_pos = start + jnp.arange(Q_BLOCK, dtype=jnp.int32)
        head_sc = jax.nn.relu(jnp.einsum('btgd,bsd->btgs', qib, k_idx).astype(f32))
        idx_sc = jnp.einsum('btg,btgs->bts', wb.astype(f32), head_sc)
        idx_sc = jnp.where(key_pos[None, None, :] <= q_pos[None, :, None], idx_sc, -jnp.inf)
        _, sel = lax.top_k(idx_sc, top_k)
        valid = sel <= q_pos[None, :, None]
        kv_sel = jax.vmap(lambda c, i: c[i])(c_kv, sel)
        logits = jnp.einsum('bthc,btkc->bthk', qb, kv_sel).astype(f32)
        bias = rel_bias.astype(f32)[t5_bucket(q_pos[None, :, None] - sel)]
        logits = logits + jnp.swapaxes(bias, -1, -2)
        logits = jnp.where(valid[:, :, None, :], logits, -jnp.inf)
        probs = jax.nn.softmax(logits, axis=-1).astype(c_kv.dtype)
        return jnp.einsum('bthk,btkc->bthc', probs, kv_sel)

    starts = jnp.arange(s // Q_BLOCK, dtype=jnp.int32) * Q_BLOCK
    out = lax.map(block, starts)
    return jnp.moveaxis(out, 0, 1).reshape(b, s, A_HEADS, KV_RANK)


def hybrid_layer(x, rel_bias, norm1_g, w_in, m_conv, m_ibias, m_fbias, m_norm_g,
                 a_qnorm_g, a_wuq, a_wuq_idx, a_kidx_g, a_kvnorm_g, a_wuk, a_wuv,
                 r_norm_g, p_m, p_a, p_r, w_out, norm2_g, w_gate, w_up, w_down):
    b, s, _ = x.shape
    h = rms_norm(x, norm1_g)
    z = h @ w_in
    split_points = [int(c) for c in np.cumsum(IN_SPLITS)[:-1]]
    (m_q, m_k, m_v, m_i, m_f, m_o, a_cq, a_kidx, a_widx, a_ckv,
     r_q, r_k, r_v, r_g, g_m, g_a, g_r) = jnp.split(z, split_points, axis=-1)

    qk = jax.nn.silu(causal_conv(jnp.concatenate([m_q, m_k], axis=-1), m_conv))
    mq, mk = jnp.split(qk, 2, axis=-1)
    hm = mlstm(mq.reshape(b, s, M_HEADS, M_QK), mk.reshape(b, s, M_HEADS, M_QK),
               m_v.reshape(b, s, M_HEADS, M_V), m_i + m_ibias, m_f + m_fbias)
    hm = head_layer_norm(hm, m_norm_g).reshape(b, s, M_WIDTH) * jax.nn.sigmoid(m_o)

    c_q = rms_norm(a_cq, a_qnorm_g)
    q = (c_q @ a_wuq).reshape(b, s, A_HEADS, A_HEAD_DIM)
    q_idx = (c_q @ a_wuq_idx).reshape(b, s, IDX_HEADS, IDX_DIM)
    k_idx = layer_norm(a_kidx, a_kidx_g)
    w_idx = a_widx * (IDX_HEADS ** -0.5 * IDX_DIM ** -0.5)
    c_kv = rms_norm(a_ckv, a_kvnorm_g)
    q_lat = jnp.einsum('bshd,hdc->bshc', q, a_wuk) * A_HEAD_DIM ** -0.5
    o_lat = dsa_attention(q_lat, c_kv, q_idx, k_idx, w_idx, rel_bias)
    ha = jnp.einsum('bshc,hcd->bshd', o_lat, a_wuv).reshape(b, s, A_WIDTH)

    pos = jnp.arange(s, dtype=jnp.float32)
    rq = rotary(r_q.reshape(b, s, R_HEADS, R_QK), pos)
    rk = rotary(r_k.reshape(b, s, R_HEADS, R_QK), pos)
    hr = retention(rq, rk, r_v.reshape(b, s, R_HEADS, R_V))
    hr = head_layer_norm(hr, r_norm_g).reshape(b, s, R_WIDTH) * jax.nn.silu(r_g)

    y = (jax.nn.sigmoid(g_m) * (hm @ p_m) + jax.nn.sigmoid(g_a) * (ha @ p_a)
         + jax.nn.sigmoid(g_r) * (hr @ p_r))
    x = x + y @ w_out

    h2 = rms_norm(x, norm2_g)
    return x + (jax.nn.silu(h2 @ w_gate) * (h2 @ w_up)) @ w_down


def setup_inputs(seed: int = 0) -> dict:
    key = jax.random.key(seed)
    keys = iter(jax.random.split(key, 32))
    f32 = jnp.float32

    def normal(shape, scale):
        return scale * jax.random.normal(next(keys), shape, f32)

    def gain(shape):
        return 1.0 + normal(shape, 0.02)

    L = DEPTH
    return {
        'x': normal((BATCH, SEQ, D_MODEL), 1.0),
        'rel_bias': normal((N_BUCKETS, A_HEADS), 0.2),
        'final_norm_g': gain((D_MODEL,)),
        'norm1_g': gain((L, D_MODEL)),
        'w_in': normal((L, D_MODEL, D_IN), D_MODEL ** -0.5),
        'm_conv': normal((L, CONV_W, 2 * M_HEADS * M_QK), CONV_W ** -0.5),
        'm_ibias': normal((L, M_HEADS), 0.1),
        'm_fbias': jnp.linspace(3.0, 6.0, M_HEADS, dtype=f32)[None, :] + normal((L, M_HEADS), 0.01),
        'm_norm_g': gain((L, M_WIDTH)),
        'a_qnorm_g': gain((L, Q_RANK)),
        'a_wuq': normal((L, Q_RANK, A_WIDTH), Q_RANK ** -0.5),
        'a_wuq_idx': normal((L, Q_RANK, IDX_HEADS * IDX_DIM), Q_RANK ** -0.5),
        'a_kidx_g': gain((L, IDX_DIM)),
        'a_kvnorm_g': gain((L, KV_RANK)),
        'a_wuk': normal((L, A_HEADS, A_HEAD_DIM, KV_RANK), A_HEAD_DIM ** -0.5),
        'a_wuv': normal((L, A_HEADS, KV_RANK, A_HEAD_DIM), KV_RANK ** -0.5),
        'r_norm_g': gain((L, R_WIDTH)),
        'p_m': normal((L, M_WIDTH, D_MODEL), M_WIDTH ** -0.5),
        'p_a': normal((L, A_WIDTH, D_MODEL), A_WIDTH ** -0.5),
        'p_r': normal((L, R_WIDTH, D_MODEL), R_WIDTH ** -0.5),
        'w_out': normal((L, D_MODEL, D_MODEL), D_MODEL ** -0.5),
        'norm2_g': gain((L, D_MODEL)),
        'w_gate': normal((L, D_MODEL, D_FF), D_MODEL ** -0.5),
        'w_up': normal((L, D_MODEL, D_FF), D_MODEL ** -0.5),
        'w_down': normal((L, D_FF, D_MODEL), D_FF ** -0.5),
    }


def reference(x, rel_bias, final_norm_g, norm1_g, w_in, m_conv, m_ibias, m_fbias, m_norm_g,
              a_qnorm_g, a_wuq, a_wuq_idx, a_kidx_g, a_kvnorm_g, a_wuk, a_wuv, r_norm_g,
              p_m, p_a, p_r, w_out, norm2_g, w_gate, w_up, w_down):
    for l in range(DEPTH):
        x = hybrid_layer(x, rel_bias, norm1_g[l], w_in[l], m_conv[l], m_ibias[l], m_fbias[l],
                         m_norm_g[l], a_qnorm_g[l], a_wuq[l], a_wuq_idx[l], a_kidx_g[l],
                         a_kvnorm_g[l], a_wuk[l], a_wuv[l], r_norm_g[l], p_m[l], p_a[l], p_r[l],
                         w_out[l], norm2_g[l], w_gate[l], w_up[l], w_down[l])
    return rms_norm(x, final_norm_g)
```

```cpp
#include <hip/hip_runtime.h>
#include <math.h>
#include <stdint.h>

namespace {
constexpr int D = 1024, NB = 16, S = 2048, M = NB * S, DIN = 7120, DFF = 2816;
constexpr int GB = 2;
constexpr int MG = GB * S;
constexpr int Z_MQ = 0, Z_MK = 256, Z_MV = 512, Z_MI = 1024, Z_MF = 1028, Z_MO = 1032, Z_CQ = 1544, Z_KIDX = 1800, Z_WIDX = 1864,
              Z_CKV = 1872, Z_RQ = 2000, Z_RK = 2512, Z_RV = 3024, Z_RG = 3536, Z_GM = 4048, Z_GA = 5072, Z_GR = 6096;

__device__ __forceinline__ float wave_sum(float v) {
#pragma unroll
    for (int o = 1; o < 64; o <<= 1) v += __shfl_xor(v, o);
    return v;
}
__device__ __forceinline__ float wave_max(float v) {
#pragma unroll
    for (int o = 1; o < 64; o <<= 1) v = fmaxf(v, __shfl_xor(v, o));
    return v;
}
__device__ __forceinline__ float sigmoidf_(float x) { return 1.f / (1.f + expf(-x)); }
__device__ __forceinline__ float siluf_(float x) { return x / (1.f + expf(-x)); }

__global__ __launch_bounds__(256) void k_gemm(const float* __restrict__ A, int lda, const float* __restrict__ Bm, int ldb, float* C, int ldc, int N, int K, int accumulate) {
    __shared__ float As[8][128 + 4];
    __shared__ float Bs[8][128 + 4];
    const int tid = threadIdx.x, tx = tid & 15, ty = tid >> 4;
    const int n0 = blockIdx.x * 128, m0 = blockIdx.y * 128;
    float acc[8][8];
#pragma unroll
    for (int i = 0; i < 8; ++i)
#pragma unroll
        for (int j = 0; j < 8; ++j) acc[i][j] = 0.f;
    for (int k0 = 0; k0 < K; k0 += 8) {
#pragma unroll
        for (int i = 0; i < 4; ++i) {
            const int e = tid + 256 * i;
            { const int r = e >> 3, c = e & 7; As[c][r] = A[(size_t)(m0 + r) * lda + k0 + c]; }
            { const int r = e >> 7, c = e & 127; Bs[r][c] = (n0 + c < N) ? Bm[(size_t)(k0 + r) * ldb + n0 + c] : 0.f; }
        }
        __syncthreads();
#pragma unroll
        for (int kk = 0; kk < 8; ++kk) {
            float a[8], b[8];
#pragma unroll
            for (int i = 0; i < 8; ++i) a[i] = As[kk][ty * 8 + i];
#pragma unroll
            for (int j = 0; j < 8; ++j) b[j] = Bs[kk][tx * 8 + j];
#pragma unroll
            for (int i = 0; i < 8; ++i)
#pragma unroll
                for (int j = 0; j < 8; ++j) acc[i][j] = fmaf(a[i], b[j], acc[i][j]);
        }
        __syncthreads();
    }
#pragma unroll
    for (int i = 0; i < 8; ++i)
#pragma unroll
        for (int j = 0; j < 8; ++j) {
            const int n = n0 + tx * 8 + j;
            if (n < N) { float* p = C + (size_t)(m0 + ty * 8 + i) * ldc + n; *p = accumulate ? (*p + acc[i][j]) : acc[i][j]; }
        }
}

__global__ __launch_bounds__(256) void k_rownorm(const float* in, int ld_in, const float* g, float* out, int ld_out, int nc, int nrows, int mode) {
    const int row = blockIdx.x * 4 + (threadIdx.x >> 6), lane = threadIdx.x & 63;
    if (row >= nrows) return;
    const float* p = in + (size_t)row * ld_in;
    float s = 0.f;
    for (int c = lane; c < nc; c += 64) s += p[c];
    const float mean = mode ? wave_sum(s) / nc : 0.f;
    float q = 0.f;
    for (int c = lane; c < nc; c += 64) { const float d = p[c] - mean; q += d * d; }
    const float rstd = 1.f / sqrtf(wave_sum(q) / nc + 1e-6f);
    float* o = out + (size_t)row * ld_out;
    for (int c = lane; c < nc; c += 64) o[c] = (p[c] - mean) * rstd * g[c];
}

__global__ __launch_bounds__(256) void k_conv_silu(const float* z, const float* w  , float* qk  ) {
    const int idx = blockIdx.x * 256 + threadIdx.x;
    const int row = idx >> 9, c = idx & 511, t = row & (S - 1);
    float a = 0.f;
#pragma unroll
    for (int j = 0; j < 4; ++j) { const int tt = t - 3 + j; if (tt >= 0) a += w[j * 512 + c] * z[(size_t)(row - 3 + j) * DIN + c]; }
    qk[idx] = siluf_(a);
}
__global__ __launch_bounds__(128) void k_mlstm(const float* qk, const float* z, const float* ibias, const float* fbias, float* hraw  ) {
    const int bb = blockIdx.x >> 2, h = blockIdx.x & 3, v = threadIdx.x;
    __shared__ float sq[64], sk[64];
    float C[64], n[64];
#pragma unroll
    for (int k = 0; k < 64; ++k) { C[k] = 0.f; n[k] = 0.f; }
    float m = 0.f;
    const float ib = ibias[h], fb = fbias[h];
    for (int t = 0; t < S; ++t) {
        const size_t row = (size_t)bb * S + t;
        __syncthreads();
        if (v < 64) sq[v] = qk[row * 512 + h * 64 + v] * 0.125f; else sk[v - 64] = qk[row * 512 + 256 + h * 64 + (v - 64)];
        __syncthreads();
        const float vv = z[row * DIN + Z_MV + h * 128 + v];
        const float ip = z[row * DIN + Z_MI + h] + ib, fp = z[row * DIN + Z_MF + h] + fb;
        const float lf = fminf(fp, 0.f) - log1pf(expf(-fabsf(fp)));
        const float mn = fmaxf(lf + m, ip);
        const float fd = expf(lf + m - mn), iw = expf(ip - mn);
        m = mn;
        float num = 0.f, den = 0.f;
#pragma unroll
        for (int k = 0; k < 64; ++k) { const float kk = sk[k] * iw; C[k] = fmaf(fd, C[k], kk * vv); n[k] = fmaf(fd, n[k], kk); num = fmaf(sq[k], C[k], num); den = fmaf(sq[k], n[k], den); }
        hraw[row * 512 + h * 128 + v] = num / fmaxf(fabsf(den), expf(-mn));
    }
}
__global__ __launch_bounds__(256) void k_headln_gate(const float* hraw, const float* g, const float* z, int zoff, float* out, int gmode) {
    const int item = blockIdx.x * 4 + (threadIdx.x >> 6), lane = threadIdx.x & 63;
    const int row = item >> 2, h = item & 3;
    const float* p = hraw + (size_t)row * 512 + h * 128;
    const float a = p[lane], b = p[lane + 64];
    const float mean = wave_sum(a + b) * (1.f / 128.f);
    const float da = a - mean, db = b - mean;
    const float rstd = 1.f / sqrtf(wave_sum(da * da + db * db) * (1.f / 128.f) + 1e-6f);
    const float* gz = z + (size_t)row * DIN + zoff + h * 128;
    const float ga = gz[lane], gb = gz[lane + 64];
    float* o = out + (size_t)row * 512 + h * 128;
    o[lane] = da * rstd * g[h * 128 + lane] * (gmode ? siluf_(ga) : sigmoidf_(ga));
    o[lane + 64] = db * rstd * g[h * 128 + lane + 64] * (gmode ? siluf_(gb) : sigmoidf_(gb));
}
__global__ __launch_bounds__(128) void k_retention(const float* z, float* hraw  ) {
    const int bb = blockIdx.x >> 2, h = blockIdx.x & 3, v = threadIdx.x;
    __shared__ float sq[128], sk[128];
    float St[128];
#pragma unroll
    for (int k = 0; k < 128; ++k) St[k] = 0.f;
    const float gamma = 1.f - exp2f(-5.f - (float)h);
    const int i = v & 63;
    const float freq = (float)pow(10000.0, -(double)((float)i / 63.0f));
    for (int t = 0; t < S; ++t) {
        const size_t row = (size_t)bb * S + t;
        __syncthreads();
        {
            const float ang = (float)t * freq, cs = cosf(ang), sn = sinf(ang);
            const float* src = z + row * DIN + (v < 64 ? Z_RQ : Z_RK) + h * 128;
            const float x1 = src[i], x2 = src[i + 64];
            float* dst = (v < 64) ? sq : sk;
            const float sc = (v < 64) ? 1.f : 0.08838834764831845f;
            dst[i] = (x1 * cs - x2 * sn) * sc; dst[i + 64] = (x1 * sn + x2 * cs) * sc;
        }
        __syncthreads();
        const float vv = z[row * DIN + Z_RV + h * 128 + v];
        float o = 0.f;
#pragma unroll
        for (int k = 0; k < 128; ++k) { St[k] = fmaf(gamma, St[k], sk[k] * vv); o = fmaf(sq[k], St[k], o); }
        hraw[row * 512 + h * 128 + v] = o;
    }
}

__device__ __forceinline__ int t5_bucket(int d) {
    if (d < 16) return d;
    int b = 16;
    b += (d >= 19); b += (d >= 21); b += (d >= 24); b += (d >= 27); b += (d >= 31); b += (d >= 35); b += (d >= 40); b += (d >= 46);
    b += (d >= 52); b += (d >= 59); b += (d >= 67); b += (d >= 77); b += (d >= 87); b += (d >= 99); b += (d >= 113);
    return b;
}
__device__ __forceinline__ unsigned fkey(float f) { const unsigned u = __float_as_uint(f); return (u & 0x80000000u) ? ~u : (u | 0x80000000u); }
__global__ __launch_bounds__(256) void k_dsa(const float* qidx  , const float* kidx  , const float* z, const float* qlat  ,
                                             const float* ckv  , const float* rel_bias  , float* olat  ) {
    __shared__ float s_q[4][1024];
    __shared__ float s_p[4][256][8];
    __shared__ int s_sel[4][256];
    const int w = threadIdx.x >> 6, lane = threadIdx.x & 63;
    const int row = blockIdx.x * 4 + w, bb = row / S, t = row % S;
    for (int i = lane; i < 512; i += 64) s_q[w][i] = qidx[(size_t)row * 512 + i];
    float wg[8];
#pragma unroll
    for (int g = 0; g < 8; ++g) wg[g] = z[(size_t)row * DIN + Z_WIDX + g] * 0.04419417382415922f;
    __syncthreads();
    unsigned key[32];
#pragma unroll
    for (int j = 0; j < 32; ++j) {
        const int s = lane + 64 * j;
        key[j] = 0u;
        if (s <= t) {
            const float* kp = kidx + ((size_t)bb * S + s) * 64;
            float acc[8];
#pragma unroll
            for (int g = 0; g < 8; ++g) acc[g] = 0.f;
            for (int d = 0; d < 64; ++d) { const float kd = kp[d];
#pragma unroll
                for (int g = 0; g < 8; ++g) acc[g] = fmaf(s_q[w][g * 64 + d], kd, acc[g]); }
            float sc = 0.f;
#pragma unroll
            for (int g = 0; g < 8; ++g) sc = fmaf(wg[g], fmaxf(acc[g], 0.f), sc);
            key[j] = fkey(sc);
        }
    }
    unsigned T = 0u; int need = 0;
    const bool all = (t + 1 <= 256);
    if (!all) {
        for (int bit = 31; bit >= 0; --bit) {
            const unsigned cand = T | (1u << bit);
            int c = 0;
#pragma unroll
            for (int j = 0; j < 32; ++j) c += (key[j] >= cand) ? 1 : 0;
            c = (int)wave_sum((float)c);
            if (c >= 256) T = cand;
        }
        int c = 0;
#pragma unroll
        for (int j = 0; j < 32; ++j) c += (key[j] > T) ? 1 : 0;
        c = (int)wave_sum((float)c);
        need = 256 - c;
    }
    int running = 0, eqrun = 0;
    const unsigned long long lt = (1ull << lane) - 1ull;
#pragma unroll
    for (int j = 0; j < 32; ++j) {
        const int s = lane + 64 * j;
        const bool valid = (s <= t);
        const bool is_eq = valid && !all && key[j] == T;
        const unsigned long long meq = __ballot(is_eq);
        const int rank_eq = eqrun + __popcll(meq & lt);
        const bool take = valid && (all || key[j] > T || (is_eq && rank_eq < need));
        const unsigned long long mt = __ballot(take);
        const int pos = running + __popcll(mt & lt);
        if (take) s_sel[w][pos] = s;
        running += __popcll(mt); eqrun += __popcll(meq);
    }
    const int nsel = running;
    __syncthreads();
    for (int i = lane; i < 1024; i += 64) s_q[w][i] = qlat[(size_t)row * 1024 + i] * 0.125f;
    __syncthreads();
    float lg[4][8];
#pragma unroll
    for (int ii = 0; ii < 4; ++ii) {
        const int i = lane + 64 * ii;
#pragma unroll
        for (int h = 0; h < 8; ++h) lg[ii][h] = -INFINITY;
        if (i < nsel) {
            const int s = s_sel[w][i];
            const float* cp = ckv + ((size_t)bb * S + s) * 128;
            float acc[8];
#pragma unroll
            for (int h = 0; h < 8; ++h) acc[h] = 0.f;
            for (int c = 0; c < 128; ++c) { const float cv = cp[c];
#pragma unroll
                for (int h = 0; h < 8; ++h) acc[h] = fmaf(s_q[w][h * 128 + c], cv, acc[h]); }
            const int bk = t5_bucket(t - s);
#pragma unroll
            for (int h = 0; h < 8; ++h) lg[ii][h] = acc[h] + rel_bias[bk * 8 + h];
        }
    }
#pragma unroll
    for (int h = 0; h < 8; ++h) {
        float mx = fmaxf(fmaxf(lg[0][h], lg[1][h]), fmaxf(lg[2][h], lg[3][h]));
        mx = wave_max(mx);
        float e[4], sm = 0.f;
#pragma unroll
        for (int ii = 0; ii < 4; ++ii) { e[ii] = (lane + 64 * ii < nsel) ? expf(lg[ii][h] - mx) : 0.f; sm += e[ii]; }
        sm = wave_sum(sm);
        const float inv = 1.f / sm;
#pragma unroll
        for (int ii = 0; ii < 4; ++ii) if (lane + 64 * ii < nsel) s_p[w][lane + 64 * ii][h] = e[ii] * inv;
    }
    __syncthreads();
    float o0[8], o1[8];
#pragma unroll
    for (int h = 0; h < 8; ++h) { o0[h] = 0.f; o1[h] = 0.f; }
    for (int i = 0; i < nsel; ++i) {
        const int s = s_sel[w][i];
        const float2 kv = *(const float2*)(ckv + ((size_t)bb * S + s) * 128 + 2 * lane);
#pragma unroll
        for (int h = 0; h < 8; ++h) { const float p = s_p[w][i][h]; o0[h] = fmaf(p, kv.x, o0[h]); o1[h] = fmaf(p, kv.y, o1[h]); }
    }
#pragma unroll
    for (int h = 0; h < 8; ++h) *(float2*)(olat + (size_t)row * 1024 + h * 128 + 2 * lane) = make_float2(o0[h], o1[h]);
}

__global__ __launch_bounds__(256) void k_merge(const float* z, const float* t1, const float* t2, const float* t3, float* y) {
    const size_t idx = (size_t)blockIdx.x * 256 + threadIdx.x;
    const size_t row = idx >> 10; const int c = (int)(idx & 1023);
    const float* zr = z + row * DIN;
    y[idx] = sigmoidf_(zr[Z_GM + c]) * t1[idx] + sigmoidf_(zr[Z_GA + c]) * t2[idx] + sigmoidf_(zr[Z_GR + c]) * t3[idx];
}
__global__ __launch_bounds__(256) void k_swiglu(const float* gate, const float* up, float* hid, size_t n) {
    const size_t idx = (size_t)blockIdx.x * 256 + threadIdx.x;
    if (idx < n) hid[idx] = siluf_(gate[idx]) * up[idx];
}
}

extern "C" void kernel_launch(void* const* d_in, const int* in_sizes, int n_in, void* d_out, int out_size, void* d_ws, size_t ws_size, hipStream_t stream) {
    const float* x = (const float*)d_in[0];
    const float* rel_bias = (const float*)d_in[1];
    const float* final_g = (const float*)d_in[2];
    float* X = (float*)d_out;
    hipMemcpyAsync(X, x, (size_t)M * D * 4, hipMemcpyDeviceToDevice, stream);
    float* ws = (float*)d_ws; size_t off = 0;
    auto take = [&](size_t n) { float* p = ws + off; off += (n + 63) & ~(size_t)63; return p; };
    float* H = take((size_t)MG * D);
    float* Z = take((size_t)MG * DIN);
    float* QK = take((size_t)MG * 512);
    float* HRAW = take((size_t)MG * 512);
    float* HM = take((size_t)MG * 512);
    float* HR = take((size_t)MG * 512);
    float* CQ = take((size_t)MG * 256);
    float* Q = take((size_t)MG * 512);
    float* QIDX = take((size_t)MG * 512);
    float* KIDX = take((size_t)MG * 64);
    float* CKV = take((size_t)MG * 128);
    float* QLAT = take((size_t)MG * 1024);
    float* OLAT = take((size_t)MG * 1024);
    float* HA = take((size_t)MG * 512);
    float* T1 = take((size_t)MG * 1024);
    float* T2 = take((size_t)MG * 1024);
    float* T3 = take((size_t)MG * 1024);
    float* Y = take((size_t)MG * 1024);
    float* GATE = Z; float* UP = Z + (size_t)MG * DFF; float* HID = GATE;
    if (off * 4 > ws_size) return;
    auto gemm = [&](const float* A, int lda, const float* Bm, int ldb, float* C, int ldc, int N, int K, int acc) {
        hipLaunchKernelGGL(k_gemm, dim3((N + 127) / 128, MG / 128), dim3(256), 0, stream, A, lda, Bm, ldb, C, ldc, N, K, acc);
    };
    for (int l = 0; l < 2; ++l) {
        const float* norm1_g = (const float*)d_in[3] + (size_t)l * D;
        const float* w_in = (const float*)d_in[4] + (size_t)l * D * DIN;
        const float* m_conv = (const float*)d_in[5] + (size_t)l * 4 * 512;
        const float* m_ibias = (const float*)d_in[6] + l * 4;
        const float* m_fbias = (const float*)d_in[7] + l * 4;
        const float* m_norm_g = (const float*)d_in[8] + l * 512;
        const float* a_qnorm_g = (const float*)d_in[9] + l * 256;
        const float* a_wuq = (const float*)d_in[10] + (size_t)l * 256 * 512;
        const float* a_wuq_idx = (const float*)d_in[11] + (size_t)l * 256 * 512;
        const float* a_kidx_g = (const float*)d_in[12] + l * 64;
        const float* a_kvnorm_g = (const float*)d_in[13] + l * 128;
        const float* a_wuk = (const float*)d_in[14] + (size_t)l * 8 * 64 * 128;
        const float* a_wuv = (const float*)d_in[15] + (size_t)l * 8 * 128 * 64;
        const float* r_norm_g = (const float*)d_in[16] + l * 512;
        const float* p_m = (const float*)d_in[17] + (size_t)l * 512 * 1024;
        const float* p_a = (const float*)d_in[18] + (size_t)l * 512 * 1024;
        const float* p_r = (const float*)d_in[19] + (size_t)l * 512 * 1024;
        const float* w_out = (const float*)d_in[20] + (size_t)l * 1024 * 1024;
        const float* norm2_g = (const float*)d_in[21] + (size_t)l * D;
        const float* w_gate = (const float*)d_in[22] + (size_t)l * D * DFF;
        const float* w_up = (const float*)d_in[23] + (size_t)l * D * DFF;
        const float* w_down = (const float*)d_in[24] + (size_t)l * DFF * D;
        for (int gi = 0; gi < NB / GB; ++gi) {
            float* Xg = X + (size_t)gi * MG * D;
            hipLaunchKernelGGL(k_rownorm, dim3(MG / 4), dim3(256), 0, stream, (const float*)Xg, D, norm1_g, H, D, D, MG, 0);
            gemm(H, D, w_in, DIN, Z, DIN, DIN, D, 0);
            hipLaunchKernelGGL(k_conv_silu, dim3(MG * 512 / 256), dim3(256), 0, stream, (const float*)Z, m_conv, QK);
            hipLaunchKernelGGL(k_mlstm, dim3(GB * 4), dim3(128), 0, stream, (const float*)QK, (const float*)Z, m_ibias, m_fbias, HRAW);
            hipLaunchKernelGGL(k_headln_gate, dim3(MG), dim3(256), 0, stream, (const float*)HRAW, m_norm_g, (const float*)Z, Z_MO, HM, 0);
            hipLaunchKernelGGL(k_retention, dim3(GB * 4), dim3(128), 0, stream, (const float*)Z, HRAW);
            hipLaunchKernelGGL(k_headln_gate, dim3(MG), dim3(256), 0, stream, (const float*)HRAW, r_norm_g, (const float*)Z, Z_RG, HR, 1);
            hipLaunchKernelGGL(k_rownorm, dim3(MG / 4), dim3(256), 0, stream, (const float*)Z + Z_CQ, DIN, a_qnorm_g, CQ, 256, 256, MG, 0);
            hipLaunchKernelGGL(k_rownorm, dim3(MG / 4), dim3(256), 0, stream, (const float*)Z + Z_KIDX, DIN, a_kidx_g, KIDX, 64, 64, MG, 1);
            hipLaunchKernelGGL(k_rownorm, dim3(MG / 4), dim3(256), 0, stream, (const float*)Z + Z_CKV, DIN, a_kvnorm_g, CKV, 128, 128, MG, 0);
            gemm(CQ, 256, a_wuq, 512, Q, 512, 512, 256, 0);
            gemm(CQ, 256, a_wuq_idx, 512, QIDX, 512, 512, 256, 0);
            for (int h = 0; h < 8; ++h) gemm(Q + h * 64, 512, a_wuk + (size_t)h * 64 * 128, 128, QLAT + h * 128, 1024, 128, 64, 0);
            hipLaunchKernelGGL(k_dsa, dim3(MG / 4), dim3(256), 0, stream, (const float*)QIDX, (const float*)KIDX, (const float*)Z, (const float*)QLAT, (const float*)CKV, rel_bias, OLAT);
            for (int h = 0; h < 8; ++h) gemm(OLAT + h * 128, 1024, a_wuv + (size_t)h * 128 * 64, 64, HA + h * 64, 512, 64, 128, 0);
            gemm(HM, 512, p_m, 1024, T1, 1024, 1024, 512, 0);
            gemm(HA, 512, p_a, 1024, T2, 1024, 1024, 512, 0);
            gemm(HR, 512, p_r, 1024, T3, 1024, 1024, 512, 0);
            hipLaunchKernelGGL(k_merge, dim3(MG * 1024 / 256), dim3(256), 0, stream, (const float*)Z, (const float*)T1, (const float*)T2, (const float*)T3, Y);
            gemm(Y, 1024, w_out, 1024, Xg, 1024, 1024, 1024, 1);
            hipLaunchKernelGGL(k_rownorm, dim3(MG / 4), dim3(256), 0, stream, (const float*)Xg, D, norm2_g, H, D, D, MG, 0);
            gemm(H, D, w_gate, DFF, GATE, DFF, DFF, D, 0);
            gemm(H, D, w_up, DFF, UP, DFF, DFF, D, 0);
            hipLaunchKernelGGL(k_swiglu, dim3((unsigned)(((size_t)MG * DFF + 255) / 256)), dim3(256), 0, stream, (const float*)GATE, (const float*)UP, HID, (size_t)MG * DFF);
            gemm(HID, DFF, w_down, D, Xg, D, D, DFF, 1);
        }
    }
    hipLaunchKernelGGL(k_rownorm, dim3(M / 4), dim3(256), 0, stream, (const float*)X, D, final_g, X, D, D, M, 0);
}
```

```cpp
#include <hip/hip_runtime.h>
#include <cstdio>
#include <cstdint>
#include <math.h>
#if defined(__HIP_DEVICE_COMPILE__)
#define ASSUME_GLOBAL(p) __builtin_assume(!__builtin_amdgcn_is_shared(p) && !__builtin_amdgcn_is_private(p))
#else
#define ASSUME_GLOBAL(p) ((void)0)
#endif
constexpr int NWAVES = 8;
constexpr int D = 1024, NB = 16, S = 2048, M = NB * S, DIN = 7120, DFF = 2816;
constexpr int Z_MQ = 0, Z_MK = 256, Z_MV = 512, Z_MI = 1024, Z_MF = 1028, Z_MO = 1032, Z_CQ = 1544, Z_KIDX = 1800, Z_WIDX = 1864,
              Z_CKV = 1872, Z_RQ = 2000, Z_RK = 2512, Z_RV = 3024, Z_RG = 3536, Z_GM = 4048;
constexpr float EPSN = 1e-6f;
#ifndef MK_PER_PHASE
#define MK_PER_PHASE 0
#endif
#ifndef ONLY_PHASE
#define ONLY_PHASE -1
#endif
#define PH_ON(k) (ONLY_PHASE < 0 || ONLY_PHASE == (k))
constexpr int N_PHASES = 16;

constexpr size_t MiB = 1u << 20;
constexpr size_t WS_CTL = 0, CTL_ZERO_BYTES = 4 * MiB;
constexpr size_t WS_ROT = 79 * MiB;
constexpr size_t WS_W = 4 * MiB;
constexpr size_t W_IN = 0, W_G = W_IN + (size_t)4096 * 1024 * 2, W_Q2 = W_G + (size_t)3072 * 1024 * 2, W_PM = W_Q2 + (size_t)1536 * 256 * 2, W_PR = W_PM + (size_t)1024 * 512 * 2,
                 W_AV = W_PR + (size_t)1024 * 512 * 2, W_OUT = W_AV + (size_t)1024 * 1024 * 2, W_GU = W_OUT + (size_t)1024 * 1024 * 2, W_DN = W_GU + (size_t)5632 * 1024 * 2,
                 W_LAYER = W_DN + (size_t)1024 * 2816 * 2;
static_assert(WS_W + 2 * W_LAYER <= 79 * MiB, "weights fit");
constexpr size_t WS_XB = 80 * MiB, WS_QLAT = 144 * MiB, WS_MV = 208 * MiB, WS_RV = 240 * MiB, WS_QIDX = 272 * MiB, WS_CKVN = 304 * MiB, WS_KIDXN = 312 * MiB, WS_MQK = 316 * MiB,
                 WS_MO = 348 * MiB, WS_RG = 380 * MiB, WS_RQ = 412 * MiB, WS_RK = 444 * MiB, WS_CQ = 476 * MiB, WS_CKV = 492 * MiB, WS_KIDX = 500 * MiB, WS_MIF = 504 * MiB, WS_WIDX = 505 * MiB,
                 WS_END = 506 * MiB;
constexpr size_t WS_YACC = 272 * MiB, WS_G8 = 336 * MiB, WS_Y = 400 * MiB;
constexpr size_t WS_HID = 144 * MiB;
constexpr int CW_TMO = 0, CW_BAR = 4096;
constexpr size_t SSQ_OFF = 64 * 1024, SSQ_STRIDE = 256 * 1024;
static_assert(SSQ_OFF + 13 * SSQ_STRIDE <= CTL_ZERO_BYTES, "ssq arrays inside the memset region");
constexpr int RING_OFF = 0, RING_BYTES = 131072, LDSCTL_OFF = RING_BYTES, MISC_OFF = LDSCTL_OFF + 320, LDS_BYTES = 147456;

namespace pg8 {
#define PG8_LAS __attribute__((address_space(3)))
typedef unsigned short bf16_t;
typedef short bf16x8 __attribute__((ext_vector_type(8)));
typedef float f32x4 __attribute__((ext_vector_type(4)));
typedef unsigned u32x4 __attribute__((ext_vector_type(4)));
typedef unsigned u32x2 __attribute__((ext_vector_type(2)));
constexpr int BM = 256, BK = 64, HALF = 128, HTB = HALF * BK * 2  , STAGE_BYTES = 8 * HTB, NXCD = 8, WGM = 8;

__host__ __device__ __forceinline__ int lds_byte(int r, int c) { const int st = (r >> 4) * 2 + (c >> 5), rr = r & 15, cc = c & 31, ob = rr * 64 + cc * 2; return st * 1024 + (ob ^ (((ob >> 9) & 1) << 5)); }
__host__ __device__ __forceinline__ void stage_rc(int b, int& R, int& C) { const int st = b / 1024, sb = b % 1024, swz = sb ^ (((sb >> 9) & 1) << 5); R = (st >> 1) * 16 + swz / 64; C = (st & 1) * 32 + (swz % 64) / 2; }
__host__ __device__ __forceinline__ int perm32(int rho) { const int n = rho >> 4, i = rho & 15; return 8 * (i >> 2) + 4 * n + (i & 3); }

struct Unit { int pm, pn; };
struct Gemm { const bf16_t* A; const bf16_t* Bt; int M, N, K; };

struct StaticOrder {
    int nM, nN, nwg, G, c;
    __host__ __device__ void init(int M, int N, int G_, int c_) { nM = M / BM; nN = N / BM; nwg = nM * nN; G = G_; c = c_; }
    __host__ __device__ bool next(int i, Unit& u) const {
        const long L = (long)i * G + c; if (L >= nwg) return false;
        int wgid = (int)L; { const int q = nwg / NXCD, r = nwg % NXCD, xcd = wgid % NXCD, off = wgid / NXCD; wgid = (xcd < r ? xcd * (q + 1) : r * (q + 1) + (xcd - r) * q) + off; }
        const int nig = WGM * nN, gid = wgid / nig, fm = gid * WGM, gsz = (nM - fm) < WGM ? (nM - fm) : WGM;
        u.pm = fm + ((wgid % nig) % gsz); u.pn = (wgid % nig) / gsz; return true;
    }
    __device__ __forceinline__ void a_ready(const Unit&) const {}
    __device__ __forceinline__ void done(const Unit&) const {}
};
__device__ __forceinline__ unsigned cvt_pk_bf16(float lo, float hi) { unsigned r; asm volatile("v_cvt_pk_bf16_f32 %0, %1, %2" : "=v"(r) : "v"(lo), "v"(hi)); return r; }
constexpr float NEPS = 1e-6f;
__device__ __forceinline__ u32x4 pack8(const f32x4& a, const f32x4& b) { u32x4 w; w.x = cvt_pk_bf16(a[0], a[1]); w.y = cvt_pk_bf16(a[2], a[3]); w.z = cvt_pk_bf16(b[0], b[1]); w.w = cvt_pk_bf16(b[2], b[3]); return w; }
__device__ __forceinline__ float sum4sq(const f32x4& a) { return (a[0] * a[0] + a[1] * a[1]) + (a[2] * a[2] + a[3] * a[3]); }
__device__ __forceinline__ float sum4(const f32x4& a) { return (a[0] + a[1]) + (a[2] + a[3]); }
__device__ __forceinline__ float red_fq(float s) { s += __shfl_xor(s, 16); s += __shfl_xor(s, 32); return s; }
__device__ __forceinline__ float fsigmoid(float x) { return __builtin_amdgcn_rcpf(1.f + __expf(-x)); }
typedef float pk_f32x2 __attribute__((ext_vector_type(2)));
typedef __bf16 pk_bf16x2 __attribute__((ext_vector_type(2)));
__device__ __forceinline__ unsigned cvt_pk_bf16v(float a, float b) { const pk_f32x2 v = {a, b}; return __builtin_bit_cast(unsigned, __builtin_convertvector(v, pk_bf16x2)); }
__device__ __forceinline__ u32x4 pack8v(const f32x4& a, const f32x4& b) { u32x4 w; w.x = cvt_pk_bf16v(a[0], a[1]); w.y = cvt_pk_bf16v(a[2], a[3]); w.z = cvt_pk_bf16v(b[0], b[1]); w.w = cvt_pk_bf16v(b[2], b[3]); return w; }
__device__ __forceinline__ f32x4 u8x4f(unsigned a) { return (f32x4){(float)(a & 0xffu), (float)((a >> 8) & 0xffu), (float)((a >> 16) & 0xffu), (float)(a >> 24)}; }
__device__ __forceinline__ f32x4 bf4_lo(unsigned a, unsigned b) { return (f32x4){__uint_as_float(a << 16), __uint_as_float(a & 0xffff0000u), __uint_as_float(b << 16), __uint_as_float(b & 0xffff0000u)}; }
__device__ __forceinline__ unsigned char* opq(unsigned char* p) { asm volatile("" : "+s"(p)); ASSUME_GLOBAL(p); return p; }
#define PG8_GAS __attribute__((address_space(1)))
typedef PG8_GAS long long* ssq_t;
__device__ __forceinline__ ssq_t ssqp(unsigned char* w, int k) { return (ssq_t)(w + WS_CTL + SSQ_OFF + (size_t)k * SSQ_STRIDE); }
__device__ __forceinline__ void gadd(ssq_t p, float v) { (void)__hip_atomic_fetch_add((PG8_GAS unsigned long long*)p, (unsigned long long)__float2ll_rn(v * 1048576.f), __ATOMIC_RELAXED, __HIP_MEMORY_SCOPE_AGENT); }
__device__ __forceinline__ float sget(ssq_t p, int row) { return (float)p[row] * (1.f / 1048576.f); }
#define EPI_ROWCOL(colexpr) int row0 = u.pm * BM + wr * 64 + fr, cl = (colexpr); asm volatile("" : "+v"(row0), "+v"(cl)); unsigned char* const w = opq(ws)

struct EpiG1 {
    static constexpr bool PERM = true, AFTER_DRAIN = false;
    unsigned char* ws; int l; const float* ibias; const float* fbias;
    __device__ __forceinline__ void operator()(const f32x4 (&acc)[2][2][4][2], const Unit& u, int wr, int wc, int fr, int fq) const {
        const int pn = u.pn; EPI_ROWCOL(wc * 32 + 8 * fq);
        const ssq_t ssq1 = ssqp(w, l * 6 + 0);
        if (pn == 7) {
            bf16_t* CKV = (bf16_t*)(w + WS_CKV); bf16_t* KIDX = (bf16_t*)(w + WS_KIDX); float* WIDX = (float*)(w + WS_WIDX); float* MIF = (float*)(w + WS_MIF);
            const ssq_t ssq_ckv = ssqp(w, l * 6 + 3); const ssq_t sum_kidx = ssqp(w, l * 6 + 4); const ssq_t ssq_kidx = ssqp(w, l * 6 + 5);
            f32x4 ib = (f32x4){0.f, 0.f, 0.f, 0.f}, fb = ib;
            if (wc == 2 && fq == 1) { ib = *(const PG8_GAS f32x4*)ibias; fb = *(const PG8_GAS f32x4*)fbias; }
#pragma unroll
            for (int ai = 0; ai < 2; ++ai)
#pragma unroll
                for (int m = 0; m < 4; ++m) {
                    const int row = row0 + ai * HALF + m * 16;
                    const float rstd = rsqrtf(sget(ssq1, row) * (1.f / 1024.f) + NEPS);
                    const f32x4 a0 = acc[ai][0][m][0] * rstd, a1 = acc[ai][0][m][1] * rstd, b0 = acc[ai][1][m][0] * rstd, b1 = acc[ai][1][m][1] * rstd;
                    *(PG8_GAS u32x4*)(CKV + (size_t)row * 128 + cl) = pack8(a0, a1);
                    const float ss = red_fq(sum4sq(a0) + sum4sq(a1));
                    if (fq == 0) gadd(ssq_ckv + row, ss);
                    if (wc < 2) {
                        *(PG8_GAS u32x4*)(KIDX + (size_t)row * 64 + cl) = pack8(b0, b1);
                        const float s1 = red_fq(sum4(b0) + sum4(b1)), s2 = red_fq(sum4sq(b0) + sum4sq(b1));
                        if (fq == 0) { gadd(sum_kidx + row, s1); gadd(ssq_kidx + row, s2); }
                    } else if (wc == 2) {
                        if (fq == 0) { *(PG8_GAS f32x4*)(WIDX + (size_t)row * 8) = b0 * 0.04419417382415922f; *(PG8_GAS f32x4*)(WIDX + (size_t)row * 8 + 4) = b1 * 0.04419417382415922f; }
                        if (fq == 1) { *(PG8_GAS f32x4*)(MIF + (size_t)row * 8) = b0 + ib; *(PG8_GAS f32x4*)(MIF + (size_t)row * 8 + 4) = b1 + fb; }
                    }
                }
            return;
        }
        if (pn >= 8 && pn < 12) {
            const bool isk = pn >= 10; bf16_t* dst = (bf16_t*)(w + (isk ? WS_RK : WS_RQ)); const int coff = 256 * ((pn - 8) & 1);
            const float* rot = (const float*)(w + WS_ROT);
            const float sc = isk ? 0.08838834764831845f : 1.f; const int i0 = 4 * (4 * wc + fq);
#pragma unroll
            for (int ai = 0; ai < 2; ++ai)
#pragma unroll
                for (int m = 0; m < 4; ++m) {
                    const int row = row0 + ai * HALF + m * 16, t = row & 2047;
                    const float rstd = rsqrtf(sget(ssq1, row) * (1.f / 1024.f) + NEPS) * sc;
                    const f32x4 cs = *(const PG8_GAS f32x4*)(rot + (size_t)t * 128 + i0), sn = *(const PG8_GAS f32x4*)(rot + (size_t)t * 128 + 64 + i0);
#pragma unroll
                    for (int bj = 0; bj < 2; ++bj) {
                        const f32x4 x1 = acc[ai][bj][m][0] * rstd, x2 = acc[ai][bj][m][1] * rstd;
                        const f32x4 o1 = x1 * cs - x2 * sn, o2 = x1 * sn + x2 * cs;
                        *(PG8_GAS u32x4*)(dst + (size_t)row * 512 + coff + bj * HALF + cl) = pack8(o1, o2);
                    }
                }
            return;
        }
        size_t boff; int ld = 512, coff;
        if (pn < 2) { boff = WS_MQK; coff = 256 * pn; } else if (pn < 4) { boff = WS_MV; coff = 256 * (pn - 2); } else if (pn < 6) { boff = WS_MO; coff = 256 * (pn - 4); }
        else if (pn == 6) { boff = WS_CQ; ld = 256; coff = 0; } else if (pn < 14) { boff = WS_RV; coff = 256 * (pn - 12); } else { boff = WS_RG; coff = 256 * (pn - 14); }
        bf16_t* base = (bf16_t*)(w + boff); const ssq_t ssq_cq = ssqp(w, l * 6 + 2);
#pragma unroll
        for (int ai = 0; ai < 2; ++ai)
#pragma unroll
            for (int m = 0; m < 4; ++m) {
                const int row = row0 + ai * HALF + m * 16;
                const float rstd = rsqrtf(sget(ssq1, row) * (1.f / 1024.f) + NEPS);
                float ss = 0.f;
#pragma unroll
                for (int bj = 0; bj < 2; ++bj) {
                    const f32x4 v0 = acc[ai][bj][m][0] * rstd, v1 = acc[ai][bj][m][1] * rstd;
                    *(PG8_GAS u32x4*)(base + (size_t)row * ld + coff + bj * HALF + cl) = pack8(v0, v1);
                    ss += sum4sq(v0) + sum4sq(v1);
                }
                if (pn == 6) { ss = red_fq(ss); if (fq == 0) gadd(ssq_cq + row, ss); }
            }
    }
};
struct EpiQ2 {
    static constexpr bool PERM = true, AFTER_DRAIN = false;
    unsigned char* ws; int l;
    __device__ __forceinline__ void operator()(const f32x4 (&acc)[2][2][4][2], const Unit& u, int wr, int wc, int fr, int fq) const {
        const int pn = u.pn; EPI_ROWCOL(wc * 32 + 8 * fq);
        const ssq_t ssq_cq = ssqp(w, l * 6 + 2);
        bf16_t* base = (bf16_t*)(w + (pn < 4 ? WS_QLAT : WS_QIDX)); const int ld = pn < 4 ? 1024 : 512, coff = pn < 4 ? 256 * pn : 256 * (pn - 4);
#pragma unroll
        for (int ai = 0; ai < 2; ++ai)
#pragma unroll
            for (int m = 0; m < 4; ++m) {
                const int row = row0 + ai * HALF + m * 16;
                const float rstd = rsqrtf(sget(ssq_cq, row) * (1.f / 256.f) + NEPS);
#pragma unroll
                for (int bj = 0; bj < 2; ++bj)
                    *(PG8_GAS u32x4*)(base + (size_t)row * ld + coff + bj * HALF + cl) = pack8(acc[ai][bj][m][0] * rstd, acc[ai][bj][m][1] * rstd);
            }
    }
};
struct EpiGate {
    static constexpr bool PERM = true, AFTER_DRAIN = false;
    unsigned char* ws; int l;
    __device__ __forceinline__ void operator()(const f32x4 (&acc)[2][2][4][2], const Unit& u, int wr, int wc, int fr, int fq) const {
        EPI_ROWCOL(u.pn * BM + wc * 32 + 8 * fq);
        const ssq_t ssq1 = ssqp(w, l * 6 + 0); unsigned char* G8 = w + WS_G8;
#pragma unroll
        for (int ai = 0; ai < 2; ++ai)
#pragma unroll
            for (int m = 0; m < 4; ++m) {
                const int row = row0 + ai * HALF + m * 16;
                const float rstd = rsqrtf(sget(ssq1, row) * (1.f / 1024.f) + NEPS);
#pragma unroll
                for (int bj = 0; bj < 2; ++bj) {
                    f32x4 v0 = acc[ai][bj][m][0] * rstd, v1 = acc[ai][bj][m][1] * rstd;
#pragma unroll
                    for (int j = 0; j < 4; ++j) { v0[j] = fsigmoid(v0[j]) * 255.f; v1[j] = fsigmoid(v1[j]) * 255.f; }
                    unsigned lo = 0u, hi = 0u;
                    lo = __builtin_amdgcn_cvt_pk_u8_f32(v0[0], 0, lo); lo = __builtin_amdgcn_cvt_pk_u8_f32(v0[1], 1, lo); lo = __builtin_amdgcn_cvt_pk_u8_f32(v0[2], 2, lo); lo = __builtin_amdgcn_cvt_pk_u8_f32(v0[3], 3, lo);
                    hi = __builtin_amdgcn_cvt_pk_u8_f32(v1[0], 0, hi); hi = __builtin_amdgcn_cvt_pk_u8_f32(v1[1], 1, hi); hi = __builtin_amdgcn_cvt_pk_u8_f32(v1[2], 2, hi); hi = __builtin_amdgcn_cvt_pk_u8_f32(v1[3], 3, hi);
                    *(PG8_GAS u32x2*)(G8 + (unsigned)(row * 1024 + cl + bj * HALF)) = (u32x2){lo, hi};
                }
            }
    }
};
struct EpiBr {
    static constexpr bool PERM = true, AFTER_DRAIN = false;
    unsigned char* ws; int mode;
    __device__ __forceinline__ void operator()(const f32x4 (&acc)[2][2][4][2], const Unit& u, int wr, int wc, int fr, int fq) const {
        EPI_ROWCOL(u.pn * BM + wc * 32 + 8 * fq);
        const unsigned char* G8 = w + WS_G8; bf16_t* Y = (bf16_t*)(w + WS_Y); bf16_t* YACC = (bf16_t*)(w + WS_YACC);
#pragma unroll
        for (int ai = 0; ai < 2; ++ai)
#pragma unroll
            for (int m = 0; m < 4; ++m) {
                const int row = row0 + ai * HALF + m * 16;
#pragma unroll
                for (int bj = 0; bj < 2; ++bj) {
                    const unsigned o = (unsigned)(row * 1024 + cl + bj * HALF), ob = 2u * o;
                    const u32x2 g = *(const PG8_GAS u32x2*)(G8 + o);
                    f32x4 v0 = acc[ai][bj][m][0] * (u8x4f(g.x) * (1.f / 255.f)), v1 = acc[ai][bj][m][1] * (u8x4f(g.y) * (1.f / 255.f));
                    if (mode != 0) { const u32x4 y = *(const PG8_GAS u32x4*)((const unsigned char*)YACC + ob); v0 += bf4_lo(y.x, y.y); v1 += bf4_lo(y.z, y.w); }
                    *(PG8_GAS u32x4*)((unsigned char*)(mode != 2 ? YACC : Y) + ob) = pack8(v0, v1);
                }
            }
    }
};
struct EpiRes {
    static constexpr bool PERM = true, AFTER_DRAIN = false;
    unsigned char* ws; int kss;
    __device__ __forceinline__ void operator()(const f32x4 (&acc)[2][2][4][2], const Unit& u, int wr, int wc, int fr, int fq) const {
        EPI_ROWCOL(u.pn * BM + wc * 32 + 8 * fq);
        bf16_t* XB = (bf16_t*)(w + WS_XB); const ssq_t ssq_next = ssqp(w, kss);
#pragma unroll
        for (int ai = 0; ai < 2; ++ai)
#pragma unroll
            for (int m = 0; m < 4; ++m) {
                const int row = row0 + ai * HALF + m * 16;
                float ss = 0.f;
#pragma unroll
                for (int bj = 0; bj < 2; ++bj) {
                    const unsigned ob = 2u * (unsigned)(row * 1024 + cl + bj * HALF);
                    const u32x4 xo = *(const PG8_GAS u32x4*)((const unsigned char*)XB + ob);
                    const f32x4 v0 = acc[ai][bj][m][0] + bf4_lo(xo.x, xo.y), v1 = acc[ai][bj][m][1] + bf4_lo(xo.z, xo.w);
                    *(PG8_GAS u32x4*)((unsigned char*)XB + ob) = pack8(v0, v1);
                    ss += sum4sq(v0) + sum4sq(v1);
                }
                ss = red_fq(ss); if (fq == 0) gadd(ssq_next + row, ss);
            }
    }
};
struct EpiUp {
    static constexpr bool PERM = true, AFTER_DRAIN = false;
    unsigned char* ws; int l;
    __device__ __forceinline__ void operator()(const f32x4 (&acc)[2][2][4][2], const Unit& u, int wr, int wc, int fr, int fq) const {
        EPI_ROWCOL(u.pn * HALF + wc * 32 + 8 * fq);
        const ssq_t ssq2 = ssqp(w, l * 6 + 1); bf16_t* HID = (bf16_t*)(w + WS_HID);
#pragma unroll
        for (int ai = 0; ai < 2; ++ai)
#pragma unroll
            for (int m = 0; m < 4; ++m) {
                const int row = row0 + ai * HALF + m * 16;
                const float rstd = rsqrtf(sget(ssq2, row) * (1.f / 1024.f) + NEPS);
                f32x4 h[2];
#pragma unroll
                for (int n = 0; n < 2; ++n) {
                    const f32x4 g = acc[ai][0][m][n] * rstd, up = acc[ai][1][m][n] * rstd;
#pragma unroll
                    for (int j = 0; j < 4; ++j) h[n][j] = g[j] * fsigmoid(g[j]) * up[j];
                }
                *(PG8_GAS u32x4*)((unsigned char*)HID + 2u * (unsigned)(row * 2816 + cl)) = pack8(h[0], h[1]);
            }
    }
};

template <class Epi, class Sched, bool ALIGN_EPI = false, bool SP2 = false>
__device__ __forceinline__ void gemm_phase(PG8_LAS unsigned char* lds, const Gemm g, const Sched& S, const Epi& E) {
    int tid_ = threadIdx.x; asm volatile("" : "+v"(tid_));
    const int tid = tid_, wid = __builtin_amdgcn_readfirstlane(tid >> 6), lane = tid & 63, wr = wid >> 2, wc = wid & 3, fr = lane & 15, fq = lane >> 4;
    int K_ = __builtin_amdgcn_readfirstlane(g.K); asm volatile("" : "+s"(K_));
    const int K = K_, nt = K / BK;
    unsigned voffA[2], voffB[2];
#pragma unroll
    for (int i = 0; i < 2; ++i) { int R, C; stage_rc(tid * 16 + i * 8192, R, C); const int Rb = Epi::PERM ? ((R & ~31) + perm32(R & 31)) : R;
        voffA[i] = (unsigned)(R * K + C) * 2u; voffB[i] = (unsigned)(Rb * K + C) * 2u; }
    const size_t kstep = (size_t)(BK * 2);
    const size_t hstep = (size_t)HALF * K * 2;
    const size_t tstep = 2 * hstep;
    const unsigned ldsw = (unsigned)wid * 1024u;
    const int aoff = lds_byte(wr * 64 + fr, fq * 8), boff = lds_byte(wc * 32 + fr, fq * 8);
#define PG8_SA(b, h) (((b) * 2 + (h)) * HTB)
#define PG8_SB(b, h) ((4 + (b) * 2 + (h)) * HTB)
#define PG8_STAGE(bufoff, gbase, voff) do { const char* sb_ = (const char*)(gbase); asm volatile("" : "+s"(sb_)); _Pragma("unroll") for (int _i = 0; _i < 2; ++_i) \
        __builtin_amdgcn_global_load_lds((const unsigned*)(sb_ + (voff)[_i]), (PG8_LAS unsigned*)(lds + (bufoff) + ldsw + _i * 8192), 16, 0, 0); } while (0)
#define PG8_LDA(dst, b, h) do { _Pragma("unroll") for (int m = 0; m < 4; ++m) _Pragma("unroll") for (int k = 0; k < 2; ++k) dst[m][k] = *(const PG8_LAS bf16x8*)(lds + PG8_SA(b, h) + aoff + m * 2048 + k * 1024); } while (0)
#define PG8_LDB(dst, b, h) do { _Pragma("unroll") for (int n = 0; n < 2; ++n) _Pragma("unroll") for (int k = 0; k < 2; ++k) dst[n][k] = *(const PG8_LAS bf16x8*)(lds + PG8_SB(b, h) + boff + n * 2048 + k * 1024); } while (0)
#define PG8_MMA(ai, bj, At, Bt) do { __builtin_amdgcn_s_setprio(1); _Pragma("unroll") for (int m = 0; m < 4; ++m) _Pragma("unroll") for (int n = 0; n < 2; ++n) _Pragma("unroll") for (int k = 0; k < 2; ++k) \
        acc[ai][bj][m][n] = __builtin_amdgcn_mfma_f32_16x16x32_bf16(Bt[n][k], At[m][k], acc[ai][bj][m][n], 0, 0, 0); __builtin_amdgcn_s_setprio(0); } while (0)
#define PG8_WAIT_V(n) asm volatile("s_waitcnt vmcnt(" #n ")" ::: "memory")
#define PG8_WAIT_L(n) asm volatile("s_waitcnt lgkmcnt(" #n ")" ::: "memory")
#define PG8_BAR __builtin_amdgcn_s_barrier()
#define PG8_SCHED __builtin_amdgcn_sched_barrier(0)
    Unit cur, nxt; int ui = 0;
    if (!S.next(0, cur)) return;
    f32x4 acc[2][2][4][2];
#pragma unroll
    for (int a = 0; a < 2; ++a)
#pragma unroll
        for (int b = 0; b < 2; ++b)
#pragma unroll
            for (int m = 0; m < 4; ++m)
#pragma unroll
                for (int n = 0; n < 2; ++n) acc[a][b][m][n] = (f32x4){0.f, 0.f, 0.f, 0.f};
    bf16x8 At[4][2], B0[2][2], B1[2][2];
    const char* cA = (const char*)g.A + (size_t)cur.pm * tstep; const char* cB = (const char*)g.Bt + (size_t)cur.pn * tstep;
    S.a_ready(cur);
    if constexpr (SP2) {
        PG8_STAGE(PG8_SB(0, 0), cB, voffB); PG8_STAGE(PG8_SB(0, 1), cB + hstep, voffB); PG8_STAGE(PG8_SA(0, 0), cA, voffA); PG8_STAGE(PG8_SA(0, 1), cA + hstep, voffA);
        if (wr == 1) PG8_BAR;
        PG8_WAIT_V(2); PG8_BAR;
        PG8_STAGE(PG8_SB(1, 0), cB + kstep, voffB); PG8_STAGE(PG8_SA(1, 0), cA + kstep, voffA); PG8_STAGE(PG8_SB(1, 1), cB + hstep + kstep, voffB);
        PG8_WAIT_V(6); PG8_BAR;
    } else {
        PG8_STAGE(PG8_SB(0, 0), cB, voffB); PG8_STAGE(PG8_SA(0, 0), cA, voffA); PG8_STAGE(PG8_SB(0, 1), cB + hstep, voffB); PG8_STAGE(PG8_SA(0, 1), cA + hstep, voffA);
        if (wr == 1) PG8_BAR;
        PG8_WAIT_V(4); PG8_BAR;
        PG8_STAGE(PG8_SB(1, 0), cB + kstep, voffB); PG8_STAGE(PG8_SA(1, 0), cA + kstep, voffA); PG8_STAGE(PG8_SB(1, 1), cB + hstep + kstep, voffB);
        PG8_WAIT_V(6); PG8_BAR;
    }
    for (;;) {
        const bool has_next = S.next(ui + 1, nxt);
        const char* nA = has_next ? (const char*)g.A + (size_t)nxt.pm * tstep : cA; const char* nB = has_next ? (const char*)g.Bt + (size_t)nxt.pn * tstep : cB;
        for (int t = 0; t < nt; t += 2) {
            asm volatile("" : "+v"(voffA[0]), "+v"(voffA[1]), "+v"(voffB[0]), "+v"(voffB[1]));
            const bool last = (t == nt - 2);
            const char* a1 = cA + (size_t)(t + 1) * kstep;
            const char* a2 = last ? nA : cA + (size_t)(t + 2) * kstep; const char* b2 = last ? nB : cB + (size_t)(t + 2) * kstep;
            const char* a3 = a2 + kstep; const char* b3 = b2 + kstep;
            if (last && has_next) S.a_ready(nxt);
            if constexpr (SP2) {
            PG8_LDB(B0, 0, 0); PG8_LDB(B1, 0, 1); PG8_SCHED; PG8_LDA(At, 0, 0); PG8_STAGE(PG8_SA(1, 1), a1 + hstep, voffA);
            PG8_WAIT_V(8); PG8_WAIT_L(0); PG8_BAR; PG8_MMA(0, 0, At, B0); PG8_MMA(0, 1, At, B1); PG8_BAR; PG8_SCHED;
            PG8_LDA(At, 0, 1); PG8_STAGE(PG8_SB(0, 0), b2, voffB); PG8_STAGE(PG8_SB(0, 1), b2 + hstep, voffB); PG8_STAGE(PG8_SA(0, 0), a2, voffA);
            PG8_WAIT_V(8); PG8_WAIT_L(0); PG8_BAR; PG8_MMA(1, 0, At, B0); PG8_MMA(1, 1, At, B1); PG8_BAR; PG8_SCHED;
            PG8_LDB(B0, 1, 0); PG8_LDB(B1, 1, 1); PG8_SCHED; PG8_LDA(At, 1, 0); PG8_STAGE(PG8_SA(0, 1), a2 + hstep, voffA);
            PG8_WAIT_V(8); PG8_WAIT_L(0); PG8_BAR; PG8_MMA(0, 0, At, B0); PG8_MMA(0, 1, At, B1); PG8_BAR; PG8_SCHED;
            PG8_LDA(At, 1, 1); PG8_STAGE(PG8_SB(1, 0), b3, voffB); PG8_STAGE(PG8_SB(1, 1), b3 + hstep, voffB); PG8_STAGE(PG8_SA(1, 0), a3, voffA);
            PG8_WAIT_V(8); PG8_WAIT_L(0); PG8_BAR; PG8_MMA(1, 0, At, B0); PG8_MMA(1, 1, At, B1); PG8_BAR; PG8_SCHED;
            } else {
            PG8_LDB(B0, 0, 0); PG8_SCHED; PG8_LDA(At, 0, 0); PG8_STAGE(PG8_SA(1, 1), a1 + hstep, voffA);
            PG8_WAIT_L(8); PG8_BAR; PG8_WAIT_L(0); PG8_MMA(0, 0, At, B0); PG8_BAR; PG8_SCHED;
            PG8_LDB(B1, 0, 1); PG8_STAGE(PG8_SB(0, 0), b2, voffB);
            PG8_BAR; PG8_WAIT_L(0); PG8_MMA(0, 1, At, B1); PG8_BAR;
            PG8_LDA(At, 0, 1); PG8_STAGE(PG8_SA(0, 0), a2, voffA);
            PG8_BAR; PG8_WAIT_L(0); PG8_MMA(1, 0, At, B0); PG8_BAR; PG8_SCHED;
            PG8_STAGE(PG8_SB(0, 1), b2 + hstep, voffB);
            PG8_WAIT_V(6); PG8_BAR; PG8_MMA(1, 1, At, B1); PG8_BAR;
            PG8_LDB(B0, 1, 0); PG8_SCHED; PG8_LDA(At, 1, 0); PG8_STAGE(PG8_SA(0, 1), a2 + hstep, voffA);
            PG8_WAIT_L(8); PG8_BAR; PG8_WAIT_L(0); PG8_MMA(0, 0, At, B0); PG8_BAR; PG8_SCHED;
            PG8_LDB(B1, 1, 1); PG8_STAGE(PG8_SB(1, 0), b3, voffB);
            PG8_BAR; PG8_WAIT_L(0); PG8_MMA(0, 1, At, B1); PG8_BAR;
            PG8_LDA(At, 1, 1); PG8_STAGE(PG8_SA(1, 0), a3, voffA);
            PG8_BAR; PG8_WAIT_L(0); PG8_MMA(1, 0, At, B0); PG8_BAR; PG8_SCHED;
            PG8_STAGE(PG8_SB(1, 1), b3 + hstep, voffB);
            PG8_WAIT_V(6); PG8_BAR; PG8_MMA(1, 1, At, B1); PG8_BAR;
            }
        }
        if constexpr (ALIGN_EPI) { if (wr == 0) PG8_BAR; }
        if constexpr (!Epi::AFTER_DRAIN) { E(acc, cur, wr, wc, fr, fq); S.done(cur); }
        if (!has_next) break;
#pragma unroll
        for (int a = 0; a < 2; ++a)
#pragma unroll
            for (int b = 0; b < 2; ++b)
#pragma unroll
                for (int m = 0; m < 4; ++m)
#pragma unroll
                    for (int n = 0; n < 2; ++n) acc[a][b][m][n] = (f32x4){0.f, 0.f, 0.f, 0.f};
        cur = nxt; cA = nA; cB = nB; ++ui;
        if constexpr (ALIGN_EPI) { if (wr == 1) PG8_BAR; }
    }
    PG8_WAIT_V(0);
    if constexpr (!ALIGN_EPI) { if (wr == 0) PG8_BAR; }
    PG8_BAR;
    if constexpr (Epi::AFTER_DRAIN) { E.fused(acc, cur, wr, wc, fr, fq, lds, wid, lane); S.done(cur); }
#undef PG8_SA
#undef PG8_SB
#undef PG8_STAGE
#undef PG8_LDA
#undef PG8_LDB
#undef PG8_MMA
#undef PG8_WAIT_V
#undef PG8_WAIT_L
#undef PG8_BAR
#undef PG8_SCHED
}
}
#define GAS __attribute__((address_space(1)))
#define LAS __attribute__((address_space(3)))
typedef unsigned short bf16;
typedef unsigned v4u __attribute__((ext_vector_type(4)));
typedef float f32x4 __attribute__((ext_vector_type(4)));
typedef short bf16x8 __attribute__((ext_vector_type(8)));
typedef GAS unsigned gu32;
typedef GAS unsigned long long gu64;
#define RLX_AGENT __ATOMIC_RELAXED, __HIP_MEMORY_SCOPE_AGENT
#define LDS_WAIT() asm volatile("s_waitcnt lgkmcnt(0)" ::: "memory")
#define WG_BAR_LDS() do { asm volatile("s_waitcnt lgkmcnt(0)" ::: "memory"); __builtin_amdgcn_s_barrier(); asm volatile("" ::: "memory"); } while (0)
#define VM_WAIT() asm volatile("s_waitcnt vmcnt(0)" ::: "memory")
__device__ __forceinline__ unsigned long long rt() { return __builtin_amdgcn_s_memrealtime(); }
__device__ __forceinline__ unsigned f2bf(float f) { unsigned u = __builtin_bit_cast(unsigned, f); return (u + 0x7fffu + ((u >> 16) & 1u)) >> 16; }
__device__ __forceinline__ unsigned pk2(float lo, float hi) { return f2bf(lo) | (f2bf(hi) << 16); }

#define XB_TMO      128
#define XB_XCNT(j)  (256  + 64 * (j))
#define XB_XSUB(j)  (1280 + 64 * (j))
#define XB_XGEN(j)  (2304 + 64 * (j))
#define XB_TOP      3328
#define XB_TOPGEN   3392
#define XCD_BAR_WORDS 3456
#define XB_SPIN_CAP (1u << 18)

__device__ __forceinline__ unsigned xb_ld(unsigned* p)              { return __hip_atomic_load(p, __ATOMIC_RELAXED, __HIP_MEMORY_SCOPE_AGENT); }
__device__ __forceinline__ unsigned xb_add(unsigned* p, unsigned v) { return __hip_atomic_fetch_add(p, v, __ATOMIC_RELAXED, __HIP_MEMORY_SCOPE_AGENT); }
__device__ __forceinline__ unsigned xb_xcc_id() { return (unsigned)__builtin_amdgcn_s_getreg((3 << 11) | 20) & 0xFu; }
#define XB_SPIN(cond, bar) do { unsigned _sp = 0; while (cond) { __builtin_amdgcn_s_sleep(1); \
    if ((++_sp & 255u) == 0u) { if (xb_ld(&(bar)[XB_TMO])) break; if (_sp > XB_SPIN_CAP) { atomicAdd(&(bar)[XB_TMO], 1u); break; } } } } while (0)

struct XcdBarrier {
    unsigned* bar; unsigned x;
    volatile LAS unsigned* st;
};

__device__ __forceinline__ XcdBarrier xcd_barrier_post(unsigned* bar, volatile LAS unsigned* st) {
    XcdBarrier b; b.bar = bar; b.x = xb_xcc_id(); b.st = st;
    if (threadIdx.x == 0) (void)xb_add(&bar[XB_XCNT(b.x)], 1u);
    return b;
}
__device__ __forceinline__ void xcd_barrier_complete(unsigned* bar, unsigned x, unsigned& nloc, unsigned& nx) {
    const unsigned G = gridDim.x * gridDim.y * gridDim.z;
    unsigned sum, cnt, mine, sp = 0u;
    for (;;) {
        sum = 0u; cnt = 0u; mine = 0u;
#pragma unroll
        for (unsigned j = 0; j < 16; ++j) { const unsigned c = xb_ld(&bar[XB_XCNT(j)]); sum += c; cnt += (c > 0u) ? 1u : 0u; mine = (j == x) ? c : mine; }
        if (sum == G) break;
        __builtin_amdgcn_s_sleep(1);
        if ((++sp & 255u) == 0u) { if (xb_ld(&bar[XB_TMO])) break; if (sp > XB_SPIN_CAP) { atomicAdd(&bar[XB_TMO], 1u); break; } }
    }
    nloc = mine > 0u ? mine : 1u; nx = cnt > 0u ? cnt : 1u;
}

__device__ __forceinline__ void xcd_barrier(const XcdBarrier& b) {
    asm volatile("s_waitcnt vmcnt(0)" ::: "memory");
    __syncthreads();
    if (threadIdx.x == 0) {
        unsigned* bar = b.bar;
        __builtin_amdgcn_s_waitcnt(0);
        unsigned nloc = b.st[0], nx = b.st[1];
        if (nloc == 0u) { xcd_barrier_complete(bar, b.x, nloc, nx); b.st[0] = nloc; b.st[1] = nx; }
        const unsigned old = xb_add(&bar[XB_XSUB(b.x)], 1u);
        const unsigned gen = old / nloc;
        if (old + 1u == (gen + 1u) * nloc) {
            __builtin_amdgcn_fence(__ATOMIC_RELEASE, "agent");
            asm volatile("s_waitcnt vmcnt(0)" ::: "memory");
            const unsigned og = xb_add(&bar[XB_TOP], 1u);
            const unsigned tg = og / nx;
            if (og + 1u == (tg + 1u) * nx) xb_add(&bar[XB_TOPGEN], 1u);
            else XB_SPIN(xb_ld(&bar[XB_TOPGEN]) == tg, bar);
            __builtin_amdgcn_fence(__ATOMIC_ACQUIRE, "agent");
            xb_add(&bar[XB_XGEN(b.x)], 1u);
            asm volatile("s_waitcnt vmcnt(0)" ::: "memory");
        } else {
            XB_SPIN(xb_ld(&bar[XB_XGEN(b.x)]) == gen, bar);
            __builtin_amdgcn_fence(__ATOMIC_ACQUIRE, "agent");
            asm volatile("s_waitcnt vmcnt(0)" ::: "memory");
        }
    }
    __syncthreads();
}
struct Args { const float* in[25]; float* out; unsigned char* ws; int ph_lo, ph_hi; };
typedef __attribute__((address_space(4))) const unsigned char kbyte;
__device__ __forceinline__ kbyte* kargs() { kbyte* p = (kbyte*)__builtin_amdgcn_kernarg_segment_ptr(); asm volatile("" : "+s"(p)); return p; }
__device__ __forceinline__ const float* ain(int i) { const float* p = (const float*)*(GAS const float* __attribute__((address_space(4))) const*)(kargs() + 8 * i); ASSUME_GLOBAL(p); return p; }
__device__ __forceinline__ float* aout() { return (float*)*(GAS float* __attribute__((address_space(4))) const*)(kargs() + 200); }
__device__ __forceinline__ unsigned char* aws() { return (unsigned char*)*(GAS unsigned char* __attribute__((address_space(4))) const*)(kargs() + 208); }
__device__ __forceinline__ int aint(int off) { return *(const int __attribute__((address_space(4)))*)(kargs() + off); }
static_assert(sizeof(Args) == 224, "Args layout");
struct Frame {
    LAS unsigned char* lds;
    unsigned char* ws;
    int wave, vcu, G;
};
__device__ __forceinline__ pg8::ssq_t ssq_arr(const Frame& F, int k) { return pg8::ssqp(F.ws, k); }
__device__ __forceinline__ bf16* wsb(const Frame& F, size_t off) { return (bf16*)(F.ws + off); }
__device__ __forceinline__ float bf2f(bf16 v) { return __uint_as_float((unsigned)v << 16); }
__device__ __forceinline__ int opaque(int v) { asm volatile("" : "+v"(v)); return v; }
__device__ __forceinline__ int opaque_s(int v) { asm volatile("" : "+s"(v)); return v; }
__device__ __forceinline__ float wave_sum(float v) {
#pragma unroll
    for (int o = 1; o < 64; o <<= 1) v += __shfl_xor(v, o);
    return v;
}
__device__ __forceinline__ float wave_max(float v) {
#pragma unroll
    for (int o = 1; o < 64; o <<= 1) v = fmaxf(v, __shfl_xor(v, o));
    return v;
}

__device__ __forceinline__ int win_srccol(int n) {
    const int t = n >> 8, c = n & 255;
    switch (t) {
        case 0: return Z_MQ + c; case 1: return Z_MK + c; case 2: case 3: return Z_MV + (n - 512); case 4: case 5: return Z_MO + (n - 1024); case 6: return Z_CQ + c;
        case 7: if (c < 128) return Z_CKV + c; if (c < 192) return Z_KIDX + (c - 128); if (c < 200) return Z_WIDX + (c - 192); if (c < 204) return Z_MI + (c - 200); if (c < 208) return Z_MF + (c - 204); return -1;
        case 8: case 9: case 10: case 11: {
            const int base = (t < 10) ? Z_RQ : Z_RK, hh = 2 * (t & 1) + (c >> 7), p = c & 127, j8 = p >> 3, e = p & 7;
            return base + hh * 128 + ((e < 4) ? (4 * j8 + e) : (64 + 4 * j8 + (e - 4))); }
        case 12: case 13: return Z_RV + (n - 3072);
        default: return Z_RG + (n - 3584);
    }
}
__device__ __forceinline__ void tr_item(const float* p, int ld, const float* kscale, int K, bf16* WT, int k0, int n0, LAS float* scr, int lane) {
#pragma unroll
    for (int i = 0; i < 8; ++i) { const int kk = (lane >> 3) + 8 * i; f32x4 v = (f32x4){0.f, 0.f, 0.f, 0.f};
        if (p) { v = *(const GAS f32x4*)(p + (size_t)(k0 + kk) * ld); if (kscale) v = v * kscale[k0 + kk]; }
        LAS float* d = scr + kk * 33 + 4 * (lane & 7); d[0] = v.x; d[1] = v.y; d[2] = v.z; d[3] = v.w; }
    LDS_WAIT(); asm volatile("" ::: "memory");
    const int c = lane & 7;
#pragma unroll
    for (int j = 0; j < 4; ++j) { const int n = (lane >> 3) + 8 * j; const LAS float* s = scr + (8 * c) * 33 + n;
        v4u o; o.x = pk2(s[0 * 33], s[1 * 33]); o.y = pk2(s[2 * 33], s[3 * 33]); o.z = pk2(s[4 * 33], s[5 * 33]); o.w = pk2(s[6 * 33], s[7 * 33]);
        *(GAS v4u*)(WT + (size_t)(n0 + n) * K + k0 + 8 * c) = o; }
    LDS_WAIT(); asm volatile("" ::: "memory");
}
__device__ __forceinline__ void p0_prologue(Frame& F) {
    LAS float* scr = (LAS float*)(F.lds + RING_OFF + F.wave * 16384);
    const int gw = F.vcu * NWAVES + F.wave, NGW = F.G * NWAVES, lane = (opaque((int)threadIdx.x) & 63);
    constexpr int I_IN = 16 * 128, I_G = 16 * 96, I_Q2 = 4 * 16, I_PM = 8 * 32, I_PR = 8 * 32, I_OUT = 16 * 32, I_GU = 16 * 176, I_DN = 44 * 32;
    constexpr int I_LAYER = I_IN + I_G + I_Q2 + I_PM + I_PR + I_OUT + I_GU + I_DN;
    for (int it = gw; it < 2 * I_LAYER; it += NGW) {
        const int l = it / I_LAYER; int r = it % I_LAYER;
        unsigned char* wl = F.ws + WS_W + (size_t)l * W_LAYER;
        const float* w_in = ain(4) + (size_t)l * D * DIN;
        const int nl = 4 * (lane & 7);
        if (r < I_IN) { const int kb = r / 128, nb = r % 128, n = 32 * nb + nl, sc = win_srccol(n);
            tr_item(sc >= 0 ? w_in + sc : nullptr, DIN, ain(3) + l * D, 1024, (bf16*)(wl + W_IN), 64 * kb, 32 * nb, scr, lane); continue; } r -= I_IN;
        if (r < I_G) { const int kb = r / 96, nb = r % 96, n = 32 * nb + nl;
            tr_item(w_in + Z_GM + n, DIN, ain(3) + l * D, 1024, (bf16*)(wl + W_G), 64 * kb, 32 * nb, scr, lane); continue; } r -= I_G;
        if (r < I_Q2) { const int kb = r / 16, nb = r % 16, n = 32 * nb + nl;
            tr_item(ain(11) + (size_t)l * 256 * 512 + n, 512, ain(9) + l * 256, 256, (bf16*)(wl + W_Q2) + (size_t)1024 * 256, 64 * kb, 32 * nb, scr, lane); continue; } r -= I_Q2;
        if (r < I_PM) { const int kb = r / 32, nb = r % 32, n = 32 * nb + nl;
            tr_item(ain(17) + (size_t)l * 512 * 1024 + n, 1024, nullptr, 512, (bf16*)(wl + W_PM), 64 * kb, 32 * nb, scr, lane); continue; } r -= I_PM;
        if (r < I_PR) { const int kb = r / 32, nb = r % 32, n = 32 * nb + nl;
            tr_item(ain(19) + (size_t)l * 512 * 1024 + n, 1024, nullptr, 512, (bf16*)(wl + W_PR), 64 * kb, 32 * nb, scr, lane); continue; } r -= I_PR;
        if (r < I_OUT) { const int kb = r / 32, nb = r % 32, n = 32 * nb + nl;
            tr_item(ain(20) + (size_t)l * 1024 * 1024 + n, 1024, nullptr, 1024, (bf16*)(wl + W_OUT), 64 * kb, 32 * nb, scr, lane); continue; } r -= I_OUT;
        if (r < I_GU) { const int kb = r / 176, nb = r % 176, n = 32 * nb + nl, tile = n >> 8, rr = n & 255;
            const float* src = (rr < 128) ? ain(22) + (size_t)l * D * DFF + 128 * tile + rr : ain(23) + (size_t)l * D * DFF + 128 * tile + (rr - 128);
            tr_item(src, DFF, ain(21) + l * D, 1024, (bf16*)(wl + W_GU), 64 * kb, 32 * nb, scr, lane); continue; } r -= I_GU;
        { const int kb = r / 32, nb = r % 32, n = 32 * nb + nl;
            tr_item(ain(24) + (size_t)l * DFF * D + n, 1024, nullptr, 2816, (bf16*)(wl + W_DN), 64 * kb, 32 * nb, scr, lane); }
    }
    for (int it = gw; it < 2 * 512; it += NGW) {
        const int l = it >> 9, r = it & 511, k0 = (r >> 4) * 8, n = (r & 15) * 64 + lane, h = n >> 7, c = n & 127;
        const float* av = ain(10) + (size_t)l * 256 * 512 + (size_t)k0 * 512 + h * 64;
        const float* bv = ain(14) + (size_t)l * 8 * 64 * 128 + (size_t)h * 64 * 128 + c;
        float acc[8];
#pragma unroll
        for (int e = 0; e < 8; ++e) acc[e] = 0.f;
#pragma unroll 16
        for (int d = 0; d < 64; ++d) { const float x = bv[(size_t)d * 128];
#pragma unroll
            for (int e = 0; e < 8; ++e) acc[e] = fmaf(av[e * 512 + d], x, acc[e]); }
        const float* gq = ain(9) + l * 256 + k0;
        v4u o; o.x = pk2(acc[0] * 0.125f * gq[0], acc[1] * 0.125f * gq[1]); o.y = pk2(acc[2] * 0.125f * gq[2], acc[3] * 0.125f * gq[3]);
        o.z = pk2(acc[4] * 0.125f * gq[4], acc[5] * 0.125f * gq[5]); o.w = pk2(acc[6] * 0.125f * gq[6], acc[7] * 0.125f * gq[7]);
        *(GAS v4u*)((bf16*)(F.ws + WS_W + (size_t)l * W_LAYER + W_Q2) + (size_t)n * 256 + k0) = o;
    }
    for (int it = gw; it < 2 * 2048; it += NGW) {
        const int l = it >> 11, r = it & 2047, kk0 = (r >> 4) * 8, n = (r & 15) * 64 + lane, h = kk0 >> 7;
        const float* av = ain(15) + (size_t)l * 8 * 128 * 64 + (size_t)kk0 * 64;
        const float* bv = ain(18) + (size_t)l * 512 * 1024 + (size_t)(h * 64) * 1024 + n;
        float acc[8];
#pragma unroll
        for (int e = 0; e < 8; ++e) acc[e] = 0.f;
#pragma unroll 16
        for (int d = 0; d < 64; ++d) { const float x = bv[(size_t)d * 1024];
#pragma unroll
            for (int e = 0; e < 8; ++e) acc[e] = fmaf(av[e * 64 + d], x, acc[e]); }
        v4u o; o.x = pk2(acc[0], acc[1]); o.y = pk2(acc[2], acc[3]); o.z = pk2(acc[4], acc[5]); o.w = pk2(acc[6], acc[7]);
        *(GAS v4u*)((bf16*)(F.ws + WS_W + (size_t)l * W_LAYER + W_AV) + (size_t)n * 1024 + kk0) = o;
    }
    const int gt = F.vcu * NWAVES * 64 + F.wave * 64 + lane, NGT = F.G * NWAVES * 64;
    float* rot = (float*)(F.ws + WS_ROT);
    for (int e = gt; e < 2048 * 64; e += NGT) {
        const int t = e >> 6, i = e & 63;
        const float freq = (float)pow(10000.0, -(double)((float)i / 63.0f)), ang = (float)t * freq;
        rot[(size_t)t * 128 + i] = cosf(ang); rot[(size_t)t * 128 + 64 + i] = sinf(ang);
    }
    pg8::ssq_t ssq = ssq_arr(F, 0); bf16* XB = wsb(F, WS_XB);
#pragma unroll 4
    for (int m = gw; m < M; m += NGW) {
        const GAS f32x4* xr = (const GAS f32x4*)(ain(0) + (size_t)m * D) + lane;
        GAS unsigned long long* o8 = (GAS unsigned long long*)(XB + (size_t)m * D) + lane; float s = 0.f;
#pragma unroll
        for (int j = 0; j < 4; ++j) { const f32x4 v = xr[64 * j]; s += (v.x * v.x + v.y * v.y) + (v.z * v.z + v.w * v.w);
            o8[64 * j] = (unsigned long long)pk2(v.x, v.y) | ((unsigned long long)pk2(v.z, v.w) << 32); }
        s = wave_sum(s); if (lane == 0) ssq[m] = __float2ll_rn(s * 1048576.f);
    }
}

__device__ __forceinline__ void p2_norms(Frame& F, int l) {
    const int gw = F.vcu * NWAVES + F.wave, NGW = F.G * NWAVES, lane = (opaque((int)threadIdx.x) & 63);
    const pg8::ssq_t ssq_ckv = ssq_arr(F, l * 6 + 3), sum_k = ssq_arr(F, l * 6 + 4), ssq_k = ssq_arr(F, l * 6 + 5);
    const bf16* CKV = wsb(F, WS_CKV); const bf16* KIDX = wsb(F, WS_KIDX); bf16* CKVN = wsb(F, WS_CKVN); bf16* KIDXN = wsb(F, WS_KIDXN);
    const int sub = lane & 15, rsel = lane >> 4;
    f32x4 gkv = *(const GAS f32x4*)(ain(12) + l * 64 + 4 * sub), gca = *(const GAS f32x4*)(ain(13) + l * 128 + 8 * sub), gcb = *(const GAS f32x4*)(ain(13) + l * 128 + 8 * sub + 4);
    for (int m4 = gw; m4 < M / 4; m4 += NGW) {
        const int m = 4 * m4 + rsel;
        const float mean = pg8::sget(sum_k, m) * (1.f / 64.f), var = pg8::sget(ssq_k, m) * (1.f / 64.f) - mean * mean, rk = rsqrtf(fmaxf(var, 0.f) + EPSN);
        const float rc = rsqrtf(pg8::sget(ssq_ckv, m) * (1.f / 128.f) + EPSN);
        const unsigned long long kq = *(const GAS unsigned long long*)(KIDX + (size_t)m * 64 + 4 * sub);
        const v4u cq = *(const GAS v4u*)(CKV + (size_t)m * 128 + 8 * sub);
        const unsigned k0 = (unsigned)kq, k1 = (unsigned)(kq >> 32);
        const unsigned o0 = pk2((__uint_as_float(k0 << 16) - mean) * rk * gkv.x, (__uint_as_float(k0 & 0xffff0000u) - mean) * rk * gkv.y);
        const unsigned o1 = pk2((__uint_as_float(k1 << 16) - mean) * rk * gkv.z, (__uint_as_float(k1 & 0xffff0000u) - mean) * rk * gkv.w);
        *(GAS unsigned long long*)(KIDXN + (size_t)m * 64 + 4 * sub) = (unsigned long long)o0 | ((unsigned long long)o1 << 32);
        v4u co;
        co.x = pk2(__uint_as_float(cq.x << 16) * rc * gca.x, __uint_as_float(cq.x & 0xffff0000u) * rc * gca.y);
        co.y = pk2(__uint_as_float(cq.y << 16) * rc * gca.z, __uint_as_float(cq.y & 0xffff0000u) * rc * gca.w);
        co.z = pk2(__uint_as_float(cq.z << 16) * rc * gcb.x, __uint_as_float(cq.z & 0xffff0000u) * rc * gcb.y);
        co.w = pk2(__uint_as_float(cq.w << 16) * rc * gcb.z, __uint_as_float(cq.w & 0xffff0000u) * rc * gcb.w);
        *(GAS v4u*)(CKVN + (size_t)m * 128 + 8 * sub) = co;
    }
}

typedef short s16x4 __attribute__((ext_vector_type(4)));
__device__ __forceinline__ unsigned offb(unsigned row, unsigned ch) { return 256u * row + 16u * (ch ^ (((row & 3u) << 2) | ((row >> 2) & 3u))); }
__device__ __forceinline__ bf16x8 frag_row(LAS unsigned char* img, int rowbase, int s, int lane) { return *(LAS bf16x8*)(img + offb(rowbase + (lane & 15), 4 * s + (lane >> 4))); }
template <bool PERM> __device__ __forceinline__ bf16x8 frag_tr(LAS unsigned char* img, int kbase, int c, int lane) {
    const unsigned g = lane >> 4, qq = (lane & 15) >> 2, pp = lane & 3;
    const unsigned r0 = kbase + (PERM ? 4 * g : 8 * g) + qq, r1 = r0 + (PERM ? 16 : 4), chn = 2 * c + (pp >> 1), bo = 8 * (pp & 1);
    const s16x4 lo = __builtin_amdgcn_ds_read_tr16_b64_v4i16((LAS s16x4*)(img + offb(r0, chn) + bo)), hi = __builtin_amdgcn_ds_read_tr16_b64_v4i16((LAS s16x4*)(img + offb(r1, chn) + bo));
    return (bf16x8){lo[0], lo[1], lo[2], lo[3], hi[0], hi[1], hi[2], hi[3]};
}
__device__ __forceinline__ unsigned offb2(unsigned row, unsigned ch) { return 256u * row + 16u * (ch ^ (((row & 3u) << 1) | ((row >> 3) & 1u) | ((((row >> 2) ^ (row >> 3)) & 1u) << 3))); }
__device__ __forceinline__ bf16x8 frag_row2(LAS unsigned char* img, int rowbase, int s, int lane) { return *(LAS bf16x8*)(img + offb2(rowbase + (lane & 15), 4 * s + (lane >> 4))); }
__device__ __forceinline__ bf16x8 frag_tr2(LAS unsigned char* img, int kbase, int c, int lane) {
    const unsigned g = lane >> 4, qq = (lane & 15) >> 2, pp = lane & 3;
    const unsigned r0 = kbase + 4 * g + qq, r1 = r0 + 16, chn = 2 * c + (pp >> 1), bo = 8 * (pp & 1);
    const s16x4 lo = __builtin_amdgcn_ds_read_tr16_b64_v4i16((LAS s16x4*)(img + offb2(r0, chn) + bo)), hi = __builtin_amdgcn_ds_read_tr16_b64_v4i16((LAS s16x4*)(img + offb2(r1, chn) + bo));
    return (bf16x8){lo[0], lo[1], lo[2], lo[3], hi[0], hi[1], hi[2], hi[3]};
}
typedef float f32x2_t __attribute__((ext_vector_type(2)));
typedef __bf16 bf16x2_t __attribute__((ext_vector_type(2)));
__device__ __forceinline__ unsigned pkbf(float a, float b) { const f32x2_t v = {a, b}; return __builtin_bit_cast(unsigned, __builtin_convertvector(v, bf16x2_t)); }
__device__ __forceinline__ bf16x8 pack_acc2(const f32x4& a, const f32x4& b) { v4u w; w.x = pkbf(a[0], a[1]); w.y = pkbf(a[2], a[3]); w.z = pkbf(b[0], b[1]); w.w = pkbf(b[2], b[3]); return __builtin_bit_cast(bf16x8, w); }
__device__ __forceinline__ v4u scale8(v4u x, float f) { v4u r;
    r.x = pkbf(__uint_as_float(x.x << 16) * f, __uint_as_float(x.x & 0xffff0000u) * f); r.y = pkbf(__uint_as_float(x.y << 16) * f, __uint_as_float(x.y & 0xffff0000u) * f);
    r.z = pkbf(__uint_as_float(x.z << 16) * f, __uint_as_float(x.z & 0xffff0000u) * f); r.w = pkbf(__uint_as_float(x.w << 16) * f, __uint_as_float(x.w & 0xffff0000u) * f); return r; }
#define MFMA16(a, b, c) __builtin_amdgcn_mfma_f32_16x16x32_bf16((a), (b), (c), 0, 0, 0)
#define SETTLE(x) do { __builtin_amdgcn_sched_barrier(0); asm volatile("s_nop 15\n\ts_nop 15"); __builtin_amdgcn_sched_barrier(0); } while (0)

__device__ __forceinline__ float row16_sum(float v) {
    v += __int_as_float(__builtin_amdgcn_update_dpp(0, __float_as_int(v), 0x121, 0xf, 0xf, false));
    v += __int_as_float(__builtin_amdgcn_update_dpp(0, __float_as_int(v), 0x122, 0xf, 0xf, false));
    v += __int_as_float(__builtin_amdgcn_update_dpp(0, __float_as_int(v), 0x124, 0xf, 0xf, false));
    v += __int_as_float(__builtin_amdgcn_update_dpp(0, __float_as_int(v), 0x128, 0xf, 0xf, false));
    return v;
}
__device__ __forceinline__ void retention_unit(Frame& F, int lyr, int b_, int h_) {
    const int b = opaque_s(b_), h = opaque_s(h_);
    const int lane = opaque((int)threadIdx.x) & 63, w = F.wave, tid = w * 64 + lane;
    LAS unsigned char* TQ = F.lds; LAS unsigned char* TK = TQ + 32768; LAS unsigned char* TV = TK + 32768; LAS unsigned char* TS = TV + 32768;
    const int g = lane >> 4, m16 = lane & 15;
    const float lg = log2f(1.f - exp2f(-5.f - (float)h));
    for (int i = tid; i < 2048; i += 512) *(LAS v4u*)(TS + 16 * i) = (v4u){0u, 0u, 0u, 0u};
    f32x4 Sacc[8];
#pragma unroll
    for (int ct = 0; ct < 8; ++ct) Sacc[ct] = (f32x4){0.f, 0.f, 0.f, 0.f};
    const bf16* RQ = wsb(F, WS_RQ); const bf16* RK = wsb(F, WS_RK); bf16* RV = wsb(F, WS_RV); const bf16* RG = wsb(F, WS_RG);
    const float* gn = ain(16) + lyr * 512 + h * 128;
    const int srow = tid >> 4, sch = tid & 15;
    const size_t gbase = ((size_t)b * S) * 512 + h * 128 + sch * 8;
    float rowdec[4];
#pragma unroll
    for (int r = 0; r < 4; ++r) rowdec[r] = exp2f((float)(16 * w + 4 * g + r + 1) * lg);
    const float colf = exp2f((float)(16 * w + m16 - 127) * lg), sdec = exp2f(128.f * lg);
    const int npair = (w >> 1) + 1;
    for (int c = 0; c < 16; ++c) {
#pragma unroll
        for (int i = 0; i < 4; ++i) { const int row = srow + 32 * i; const unsigned o = offb(row, sch); const size_t go = gbase + (size_t)(c * 128 + row) * 512;
            const v4u vq = *(const GAS v4u*)(RQ + go), vk = *(const GAS v4u*)(RK + go), vv = *(const GAS v4u*)(RV + go);
            *(LAS v4u*)(TQ + o) = vq; *(LAS v4u*)(TK + o) = scale8(vk, exp2f((float)(127 - row) * lg)); *(LAS v4u*)(TV + o) = vv; }
        WG_BAR_LDS();
        bf16x8 qf[4];
#pragma unroll
        for (int s = 0; s < 4; ++s) qf[s] = frag_row(TQ, 16 * w, s, lane);
        f32x4 O[8];
#pragma unroll
        for (int ct = 0; ct < 8; ++ct) { f32x4 a = (f32x4){0.f, 0.f, 0.f, 0.f};
#pragma unroll
            for (int s = 0; s < 4; ++s) a = MFMA16(qf[s], frag_tr<false>(TS, 32 * s, ct, lane), a);
            SETTLE(a);
#pragma unroll
            for (int r = 0; r < 4; ++r) a[r] *= rowdec[r];
            O[ct] = a; }
        for (int jp = 0; jp < npair; ++jp) {
            f32x4 c1[2];
#pragma unroll
            for (int hb = 0; hb < 2; ++hb) { f32x4 a = (f32x4){0.f, 0.f, 0.f, 0.f}; const int rb = 2 * jp + hb;
#pragma unroll
                for (int s = 0; s < 4; ++s) a = MFMA16(frag_row(TK, 16 * rb, s, lane), qf[s], a);
                SETTLE(a);
#pragma unroll
                for (int r = 0; r < 4; ++r) a[r] = (16 * rb + 4 * g + r <= 16 * w + m16) ? a[r] * colf : 0.f;
                c1[hb] = a; }
            const bf16x8 pf = pack_acc2(c1[0], c1[1]);
#pragma unroll
            for (int ct = 0; ct < 8; ++ct) O[ct] = MFMA16(pf, frag_tr<true>(TV, 32 * jp, ct, lane), O[ct]);
        }
#pragma unroll
        for (int ct = 0; ct < 8; ++ct) Sacc[ct] = Sacc[ct] * sdec;
#pragma unroll
        for (int s = 0; s < 4; ++s) { const bf16x8 kt = frag_tr<false>(TK, 32 * s, w, lane);
#pragma unroll
            for (int ct = 0; ct < 8; ++ct) Sacc[ct] = MFMA16(kt, frag_tr<false>(TV, 32 * s, ct, lane), Sacc[ct]); }
        float mean[4], rstd[4];
#pragma unroll
        for (int r = 0; r < 4; ++r) { float s1 = 0.f;
#pragma unroll
            for (int ct = 0; ct < 8; ++ct) s1 += O[ct][r];
            s1 = row16_sum(s1);
            mean[r] = s1 * (1.f / 128.f); float s2 = 0.f;
#pragma unroll
            for (int ct = 0; ct < 8; ++ct) { const float d = O[ct][r] - mean[r]; s2 += d * d; }
            s2 = row16_sum(s2);
            rstd[r] = rsqrtf(s2 * (1.f / 128.f) + EPSN); }
        { const int lq_ = opaque(lane), gq = lq_ >> 4, mq = lq_ & 15;
          LAS unsigned char* st = TQ + 4096 * w;
#pragma unroll
          for (int ct = 0; ct < 8; ++ct) { const float gv = gn[16 * ct + mq];
#pragma unroll
            for (int r = 0; r < 4; ++r) *(LAS bf16*)(st + (4 * gq + r) * 256 + (16 * ct + mq) * 2) = (bf16)f2bf((O[ct][r] - mean[r]) * rstd[r] * gv); }
          LDS_WAIT(); asm volatile("" ::: "memory");
#pragma unroll
          for (int i = 0; i < 4; ++i) { const int n = lq_ + 64 * i, row = n >> 4, ch = n & 15;
            const v4u xv = *(LAS v4u*)(st + row * 256 + ch * 16);
            const size_t o = ((size_t)b * S + c * 128 + 16 * w + row) * 512 + h * 128 + ch * 8;
            const v4u gt = *(const GAS v4u*)(RG + o); v4u ov;
            { const float g0 = __uint_as_float(gt.x << 16), g1 = __uint_as_float(gt.x & 0xffff0000u); ov.x = pkbf(__uint_as_float(xv.x << 16) * g0 / (1.f + __expf(-g0)), __uint_as_float(xv.x & 0xffff0000u) * g1 / (1.f + __expf(-g1))); }
            { const float g0 = __uint_as_float(gt.y << 16), g1 = __uint_as_float(gt.y & 0xffff0000u); ov.y = pkbf(__uint_as_float(xv.y << 16) * g0 / (1.f + __expf(-g0)), __uint_as_float(xv.y & 0xffff0000u) * g1 / (1.f + __expf(-g1))); }
            { const float g0 = __uint_as_float(gt.z << 16), g1 = __uint_as_float(gt.z & 0xffff0000u); ov.z = pkbf(__uint_as_float(xv.z << 16) * g0 / (1.f + __expf(-g0)), __uint_as_float(xv.z & 0xffff0000u) * g1 / (1.f + __expf(-g1))); }
            { const float g0 = __uint_as_float(gt.w << 16), g1 = __uint_as_float(gt.w & 0xffff0000u); ov.w = pkbf(__uint_as_float(xv.w << 16) * g0 / (1.f + __expf(-g0)), __uint_as_float(xv.w & 0xffff0000u) * g1 / (1.f + __expf(-g1))); }
            *(GAS v4u*)(RV + o) = ov; }
        }
        WG_BAR_LDS();
        const int lo_ = opaque(lane), go = lo_ >> 4, mo = lo_ & 15;
#pragma unroll
        for (int ct = 0; ct < 8; ++ct)
#pragma unroll
            for (int r = 0; r < 4; ++r) { const unsigned row = 16 * w + 4 * go + r, col = 16 * ct + mo;
                *(LAS bf16*)(TS + offb(row, col >> 3) + 2 * (col & 7)) = (bf16)f2bf(Sacc[ct][r]); }
    }
    WG_BAR_LDS();
}
__device__ __forceinline__ float log_sigmoid(float x) { return fminf(x, 0.f) - log1pf(__expf(-fabsf(x))); }
__device__ __forceinline__ void mlstm_unit(Frame& F, int lyr, int b_, int h_) {
    const int b = opaque_s(b_), h = opaque_s(h_);
    const int lane = opaque((int)threadIdx.x) & 63, w = F.wave, tid = w * 64 + lane;
    LAS unsigned char* TQK = F.lds; LAS unsigned char* TV = TQK + 32768; LAS unsigned char* TS = TV + 32768; LAS unsigned char* TN = TS + 16384;
    LAS float* GB = (LAS float*)(TN + 16384);
    LAS float* G_bc = GB, *G_u = GB + 128, *G_pm = GB + 256, *G_s0 = GB + 384, *G_sc = GB + 640;
    const int g = lane >> 4, m16 = lane & 15;
    for (int i = tid; i < 2048; i += 512) *(LAS v4u*)(TS + 16 * i) = (v4u){0u, 0u, 0u, 0u};
    f32x4 Cacc[4], nacc = (f32x4){0.f, 0.f, 0.f, 0.f};
#pragma unroll
    for (int j = 0; j < 4; ++j) Cacc[j] = (f32x4){0.f, 0.f, 0.f, 0.f};
    const bf16* MQK = wsb(F, WS_MQK); bf16* MV = wsb(F, WS_MV); const bf16* MO = wsb(F, WS_MO); const float* MIF = (const float*)(F.ws + WS_MIF);
    const float* gn = ain(8) + lyr * 512 + h * 128;
    const int srow = tid >> 4, sch = tid & 15;
    const int qkcol = (sch < 8) ? (h * 64 + 8 * sch) : (256 + h * 64 + 8 * (sch - 8));
    float cw[4][8];
    { const float* cv = ain(5) + (size_t)lyr * 4 * 512 + qkcol;
#pragma unroll
      for (int j = 0; j < 4; ++j)
#pragma unroll
        for (int e = 0; e < 8; ++e) cw[j][e] = cv[j * 512 + e]; }
    const float qsc = (sch < 8) ? 0.125f : 1.f;
    const bf16x8 ones = (bf16x8){0x3f80, 0x3f80, 0x3f80, 0x3f80, 0x3f80, 0x3f80, 0x3f80, 0x3f80};
    float m_st = 0.f;
    const int npair = (w >> 1) + 1, kt = w & 3, vt0 = 4 * (w >> 2);
    for (int c = 0; c < 16; ++c) {
#pragma unroll 1
        for (int i = 0; i < 4; ++i) { const int row = srow + 32 * i, t = c * 128 + row; const size_t rbase = ((size_t)b * S + t) * 512;
            float a[8];
#pragma unroll
            for (int e = 0; e < 8; ++e) a[e] = 0.f;
#pragma unroll
            for (int j = 0; j < 4; ++j) { const int tt = t - 3 + j;
                if (tt >= 0) { const v4u x = *(const GAS v4u*)(MQK + (rbase - (size_t)(3 - j) * 512) + qkcol);
                    a[0] = fmaf(cw[j][0], __uint_as_float(x.x << 16), a[0]); a[1] = fmaf(cw[j][1], __uint_as_float(x.x & 0xffff0000u), a[1]);
                    a[2] = fmaf(cw[j][2], __uint_as_float(x.y << 16), a[2]); a[3] = fmaf(cw[j][3], __uint_as_float(x.y & 0xffff0000u), a[3]);
                    a[4] = fmaf(cw[j][4], __uint_as_float(x.z << 16), a[4]); a[5] = fmaf(cw[j][5], __uint_as_float(x.z & 0xffff0000u), a[5]);
                    a[6] = fmaf(cw[j][6], __uint_as_float(x.w << 16), a[6]); a[7] = fmaf(cw[j][7], __uint_as_float(x.w & 0xffff0000u), a[7]); } }
#pragma unroll
            for (int e = 0; e < 8; ++e) a[e] = a[e] / (1.f + __expf(-a[e])) * qsc;
            v4u o; o.x = pkbf(a[0], a[1]); o.y = pkbf(a[2], a[3]); o.z = pkbf(a[4], a[5]); o.w = pkbf(a[6], a[7]);
            *(LAS v4u*)(TQK + offb(row, sch)) = o;
            *(LAS v4u*)(TV + offb(row, sch)) = *(const GAS v4u*)(MV + rbase + h * 128 + sch * 8); }
        if (w == 0) {
            const size_t r0 = (size_t)b * S + c * 128;
            float x0 = log_sigmoid(MIF[(r0 + lane) * 8 + 4 + h]), x1 = log_sigmoid(MIF[(r0 + lane + 64) * 8 + 4 + h]);
            const float li0 = MIF[(r0 + lane) * 8 + h], li1 = MIF[(r0 + lane + 64) * 8 + h];
#pragma unroll 1
            for (int d = 1; d < 128; d <<= 1) { G_s0[lane] = x0; G_s0[lane + 64] = x1; LDS_WAIT(); asm volatile("" ::: "memory");
                const float y0 = (lane >= d) ? G_s0[lane - d] : 0.f, y1 = G_s0[lane + 64 - d]; LDS_WAIT(); asm volatile("" ::: "memory"); x0 += y0; x1 += y1; }
            G_bc[lane] = x0; G_bc[lane + 64] = x1;
            float u0 = li0 - x0, u1 = li1 - x1; G_u[lane] = u0; G_u[lane + 64] = u1;
            const float blast = __int_as_float(__builtin_amdgcn_readlane(__float_as_int(x1), 63));
#pragma unroll 1
            for (int d = 1; d < 128; d <<= 1) { G_s0[lane] = u0; G_s0[lane + 64] = u1; LDS_WAIT(); asm volatile("" ::: "memory");
                const float y0 = (lane >= d) ? G_s0[lane - d] : -INFINITY, y1 = G_s0[lane + 64 - d]; LDS_WAIT(); asm volatile("" ::: "memory"); u0 = fmaxf(u0, y0); u1 = fmaxf(u1, y1); }
            u0 = fmaxf(u0, m_st); u1 = fmaxf(u1, m_st);
            G_pm[lane] = u0; G_pm[lane + 64] = u1;
            const float pml = __int_as_float(__builtin_amdgcn_readlane(__float_as_int(u1), 63));
            if (lane == 0) { G_sc[0] = m_st; G_sc[1] = pml; }
            m_st = blast + pml;
        }
        WG_BAR_LDS();
        const int lc = opaque(lane), gq = lc >> 4, mq = lc & 15;
        const float mst_c = G_sc[0], pm_last = G_sc[1];
        bf16x8 qf[2];
#pragma unroll
        for (int s = 0; s < 2; ++s) qf[s] = frag_row(TQK, 16 * w, s, lc);
        f32x4 O[9];
        const f32x4 pmr = *(LAS f32x4*)(G_pm + 16 * w + 4 * gq), bcr = *(LAS f32x4*)(G_bc + 16 * w + 4 * gq);
        float wint[4];
#pragma unroll
        for (int r = 0; r < 4; ++r) wint[r] = __expf(mst_c - pmr[r]);
#pragma unroll
        for (int ct = 0; ct < 9; ++ct) { f32x4 a = (f32x4){0.f, 0.f, 0.f, 0.f};
#pragma unroll
            for (int s = 0; s < 2; ++s) a = MFMA16(qf[s], (ct < 8) ? frag_tr<false>(TS, 32 * s, ct, lc) : frag_tr<false>(TN, 32 * s, 0, lc), a);
#pragma unroll
            for (int r = 0; r < 4; ++r) a[r] *= wint[r];
            O[ct] = a; }
        const float pml_ = G_pm[16 * w + mq];
        for (int jp = 0; jp < npair; ++jp) {
            f32x4 c1[2];
#pragma unroll
            for (int hb = 0; hb < 2; ++hb) { f32x4 a = (f32x4){0.f, 0.f, 0.f, 0.f}; const int rb = 2 * jp + hb;
#pragma unroll
                for (int s = 0; s < 2; ++s) a = MFMA16(frag_row(TQK, 16 * rb, 2 + s, lc), qf[s], a);
                const f32x4 ur = *(LAS f32x4*)(G_u + 16 * rb + 4 * gq);
#pragma unroll
                for (int r = 0; r < 4; ++r) a[r] = (16 * rb + 4 * gq + r <= 16 * w + mq) ? a[r] * __expf(ur[r] - pml_) : 0.f;
                c1[hb] = a; }
            const bf16x8 pf = pack_acc2(c1[0], c1[1]);
#pragma unroll
            for (int ct = 0; ct < 8; ++ct) O[ct] = MFMA16(pf, frag_tr<true>(TV, 32 * jp, ct, lc), O[ct]);
            O[8] = MFMA16(pf, ones, O[8]);
        }
        { const float decay = __expf(mst_c - pm_last);
#pragma unroll
          for (int j = 0; j < 4; ++j) Cacc[j] = Cacc[j] * decay;
          nacc = nacc * decay;
#pragma unroll
          for (int s = 0; s < 4; ++s) { const bf16x8 kraw = frag_tr<false>(TQK, 32 * s, 4 + kt, lc);
            const f32x4 ua = *(LAS f32x4*)(G_u + 32 * s + 8 * gq), ub = *(LAS f32x4*)(G_u + 32 * s + 8 * gq + 4);
            const v4u kr = __builtin_bit_cast(v4u, kraw); v4u ks;
            ks.x = pkbf(__uint_as_float(kr.x << 16) * __expf(ua[0] - pm_last), __uint_as_float(kr.x & 0xffff0000u) * __expf(ua[1] - pm_last));
            ks.y = pkbf(__uint_as_float(kr.y << 16) * __expf(ua[2] - pm_last), __uint_as_float(kr.y & 0xffff0000u) * __expf(ua[3] - pm_last));
            ks.z = pkbf(__uint_as_float(kr.z << 16) * __expf(ub[0] - pm_last), __uint_as_float(kr.z & 0xffff0000u) * __expf(ub[1] - pm_last));
            ks.w = pkbf(__uint_as_float(kr.w << 16) * __expf(ub[2] - pm_last), __uint_as_float(kr.w & 0xffff0000u) * __expf(ub[3] - pm_last));
            const bf16x8 kw = __builtin_bit_cast(bf16x8, ks);
#pragma unroll
            for (int j = 0; j < 4; ++j) Cacc[j] = MFMA16(kw, frag_tr<false>(TV, 32 * s, vt0 + j, lc), Cacc[j]);
            nacc = MFMA16(kw, ones, nacc); } }
        float mean[4], rstd[4];
#pragma unroll
        for (int r = 0; r < 4; ++r) { const float inv = 1.f / fmaxf(fabsf(O[8][r]), __expf(-(bcr[r] + pmr[r]))); float s1 = 0.f;
#pragma unroll
            for (int ct = 0; ct < 8; ++ct) { O[ct][r] *= inv; s1 += O[ct][r]; }
            s1 = row16_sum(s1); mean[r] = s1 * (1.f / 128.f); float s2 = 0.f;
#pragma unroll
            for (int ct = 0; ct < 8; ++ct) { const float d = O[ct][r] - mean[r]; s2 += d * d; }
            s2 = row16_sum(s2); rstd[r] = rsqrtf(s2 * (1.f / 128.f) + EPSN); }
        WG_BAR_LDS();
#pragma unroll
        for (int j = 0; j < 4; ++j)
#pragma unroll
            for (int r = 0; r < 4; ++r) { const unsigned row = 16 * kt + 4 * gq + r, col = 16 * (vt0 + j) + mq;
                *(LAS bf16*)(TS + offb(row, col >> 3) + 2 * (col & 7)) = (bf16)f2bf(Cacc[j][r]); }
        if (w < 4) {
#pragma unroll
            for (int r = 0; r < 4; ++r) { const unsigned row = 16 * kt + 4 * gq + r;
                *(LAS bf16*)(TN + offb(row, mq >> 3) + 2 * (mq & 7)) = (bf16)f2bf(nacc[r]); } }
        { LAS unsigned char* st = TQK + 4096 * w;
#pragma unroll
          for (int ct = 0; ct < 8; ++ct) { const float gv = gn[16 * ct + mq];
#pragma unroll
            for (int r = 0; r < 4; ++r) *(LAS bf16*)(st + (4 * gq + r) * 256 + (16 * ct + mq) * 2) = (bf16)f2bf((O[ct][r] - mean[r]) * rstd[r] * gv); }
          LDS_WAIT(); asm volatile("" ::: "memory");
#pragma unroll 1
          for (int i = 0; i < 4; ++i) { const int n = lc + 64 * i, row = n >> 4, ch = n & 15;
            const v4u xv = *(LAS v4u*)(st + row * 256 + ch * 16);
            const size_t o = ((size_t)b * S + c * 128 + 16 * w + row) * 512 + h * 128 + ch * 8;
            const v4u gt = *(const GAS v4u*)(MO + o); v4u ov;
            { const float g0 = __uint_as_float(gt.x << 16), g1 = __uint_as_float(gt.x & 0xffff0000u); ov.x = pkbf(__uint_as_float(xv.x << 16) / (1.f + __expf(-g0)), __uint_as_float(xv.x & 0xffff0000u) / (1.f + __expf(-g1))); }
            { const float g0 = __uint_as_float(gt.y << 16), g1 = __uint_as_float(gt.y & 0xffff0000u); ov.y = pkbf(__uint_as_float(xv.y << 16) / (1.f + __expf(-g0)), __uint_as_float(xv.y & 0xffff0000u) / (1.f + __expf(-g1))); }
            { const float g0 = __uint_as_float(gt.z << 16), g1 = __uint_as_float(gt.z & 0xffff0000u); ov.z = pkbf(__uint_as_float(xv.z << 16) / (1.f + __expf(-g0)), __uint_as_float(xv.z & 0xffff0000u) / (1.f + __expf(-g1))); }
            { const float g0 = __uint_as_float(gt.w << 16), g1 = __uint_as_float(gt.w & 0xffff0000u); ov.w = pkbf(__uint_as_float(xv.w << 16) / (1.f + __expf(-g0)), __uint_as_float(xv.w & 0xffff0000u) / (1.f + __expf(-g1))); }
            *(GAS v4u*)(MV + o) = ov; }
        }
        WG_BAR_LDS();
    }
    WG_BAR_LDS();
}
__device__ __forceinline__ int t5_bucket(int d) {
    if (d < 16) return d;
    int b = 16;
    b += (d >= 19); b += (d >= 21); b += (d >= 24); b += (d >= 27); b += (d >= 31); b += (d >= 35); b += (d >= 40); b += (d >= 46);
    b += (d >= 52); b += (d >= 59); b += (d >= 67); b += (d >= 77); b += (d >= 87); b += (d >= 99); b += (d >= 113);
    return b;
}
__device__ __forceinline__ unsigned wave_incl_scan_u32(unsigned x) {
    int v = (int)x;
    v += __builtin_amdgcn_update_dpp(0, v, 0x111, 0xf, 0xf, true);
    v += __builtin_amdgcn_update_dpp(0, v, 0x112, 0xf, 0xf, true);
    v += __builtin_amdgcn_update_dpp(0, v, 0x114, 0xf, 0xf, true);
    v += __builtin_amdgcn_update_dpp(0, v, 0x118, 0xf, 0xf, true);
    v += __builtin_amdgcn_update_dpp(0, v, 0x142, 0xa, 0xf, false);
    v += __builtin_amdgcn_update_dpp(0, v, 0x143, 0xc, 0xf, false);
    return (unsigned)v;
}
__device__ __forceinline__ float relu0(float x) { const int b = __builtin_bit_cast(int, x); return __builtin_bit_cast(float, b > 0 ? b : 0); }
__device__ __forceinline__ unsigned fkey(float f) { const unsigned u = __float_as_uint(f); return u ^ ((unsigned)((int)u >> 31) | 0x80000000u); }
__device__ __forceinline__ void dsa_phase(Frame& F, int l) {
    const int lane = (opaque((int)threadIdx.x) & 63), w = F.wave;
    LAS float* s_q = (LAS float*)(F.lds + w * 13312);
    LAS unsigned* s_qb = (LAS unsigned*)s_q;
    LAS float* s_p = s_q + 1024;
    LAS int* s_sel = (LAS int*)(s_p + 2048);
    const bf16* QIDX = wsb(F, WS_QIDX); const bf16* KIDXN = wsb(F, WS_KIDXN); bf16* QLAT = wsb(F, WS_QLAT); const bf16* CKVN = wsb(F, WS_CKVN);
    const float* WIDX = (const float*)(F.ws + WS_WIDX); const float* rel_bias = ain(1);
    LAS unsigned char* img = (LAS unsigned char*)s_p; LAS float* s_red = s_q + 512; LAS unsigned char* s_out = (LAS unsigned char*)s_p;
    const int g4 = lane >> 4, m16 = lane & 15, hd = m16 & 7;
    LAS float* s_bd = (LAS float*)(F.lds + LDSCTL_OFF + 1024);
    for (int i = lane; i < 1024; i += 64) s_bd[i] = rel_bias[t5_bucket(i >> 3) * 8 + (i & 7)] * 1.4426950408889634f;
    float bmax = 0.f;
    for (int k = 0; k < 32; ++k) bmax = fmaxf(bmax, fabsf(rel_bias[k * 8 + hd]));
    float gmax = fmaxf(fabsf(ain(13)[l * 128 + lane]), fabsf(ain(13)[l * 128 + 64 + lane]));
    s_red[lane] = gmax; LDS_WAIT(); asm volatile("" ::: "memory");
    for (int k = 0; k < 64; ++k) gmax = fmaxf(gmax, s_red[k]);
    const float BKV = 1.01f * 11.313708498984761f * gmax;
    LDS_WAIT(); asm volatile("" ::: "memory");
    const bf16x8 ones = (bf16x8){0x3f80, 0x3f80, 0x3f80, 0x3f80, 0x3f80, 0x3f80, 0x3f80, 0x3f80};
    gu32* ctr = (gu32*)(F.ws + WS_CTL) + 16 + l;
    LAS unsigned* hist = (LAS unsigned*)s_q;
    LAS int* s_selB = (LAS int*)(s_q + 256);
    LAS unsigned* s_keyB = (LAS unsigned*)img;
    LAS unsigned char* kring = F.lds + 8 * 13312;
    LAS unsigned* s_tk = (LAS unsigned*)(F.lds + LDSCTL_OFF + 5120);
    for (;;) {
        WG_BAR_LDS();
        if (opaque((int)threadIdx.x) == 0) *s_tk = __hip_atomic_fetch_add(ctr, 1u, RLX_AGENT);
        WG_BAR_LDS();
        const unsigned tk = (unsigned)__builtin_amdgcn_readfirstlane((int)*s_tk);
        if (tk >= (unsigned)(M / 16)) break;
        const int tkk = M / 16 - 1 - (int)tk, bb = tkk & 15, P = tkk >> 4, tA = 16 * P + 2 * w + 1, tB = tA - 1, rowA = bb * 2048 + tA, rowB = rowA - 1;
        bf16x8 qA[2]; float wr[4];
        { const int rq = (m16 < 8) ? rowA : rowB;
#pragma unroll
          for (int s2 = 0; s2 < 2; ++s2) qA[s2] = __builtin_bit_cast(bf16x8, *(const GAS v4u*)(QIDX + (size_t)rq * 512 + hd * 64 + 32 * s2 + 8 * g4));
          const int rw = (g4 < 2) ? rowA : rowB;
#pragma unroll
          for (int r = 0; r < 4; ++r) wr[r] = WIDX[(size_t)rw * 8 + 4 * (g4 & 1) + r]; }
        LAS float* scr = s_q + 256;
        unsigned key[32];
        const int nj = ((16 * P + 15) >> 6) + 1;
#define DSA_KDMA(jj) __builtin_amdgcn_global_load_lds((const unsigned*)((const char*)(KIDXN + ((size_t)bb * S + 64 * (jj)) * 64) + 128 * (16 * (w >> 1) + m16) + 64 * (w & 1) + 16 * g4), \
                                                      (LAS unsigned*)(kring + ((jj) % 3) * 8192 + w * 1024), 16, 0, 0)
        DSA_KDMA(0); if (nj > 1) DSA_KDMA(1);
#pragma unroll
        for (int j = 0; j < 32; ++j) {
            key[j] = 0u;
            if (j < nj) {
                if (j + 1 < nj) asm volatile("s_waitcnt vmcnt(1)" ::: "memory"); else asm volatile("s_waitcnt vmcnt(0)" ::: "memory");
                __builtin_amdgcn_s_barrier();
                asm volatile("" ::: "memory");
                if (j + 2 < nj) DSA_KDMA(j + 2);
                v4u kfr[4][2];
#pragma unroll
                for (int bq = 0; bq < 4; ++bq)
#pragma unroll
                    for (int s2 = 0; s2 < 2; ++s2) kfr[bq][s2] = *(const LAS v4u*)(kring + (j % 3) * 8192 + (bq * 2 + s2) * 1024 + lane * 16);
                float part[4]; f32x4 ab[4];
#pragma unroll
                for (int bq = 0; bq < 4; ++bq) ab[bq] = MFMA16(qA[0], __builtin_bit_cast(bf16x8, kfr[bq][0]), ((f32x4){0.f, 0.f, 0.f, 0.f}));
#pragma unroll
                for (int bq = 0; bq < 4; ++bq) ab[bq] = MFMA16(qA[1], __builtin_bit_cast(bf16x8, kfr[bq][1]), ab[bq]);
#pragma unroll
                for (int bq = 0; bq < 4; ++bq) part[bq] = (wr[0] * relu0(ab[bq][0]) + wr[1] * relu0(ab[bq][1])) + (wr[2] * relu0(ab[bq][2]) + wr[3] * relu0(ab[bq][3]));
#pragma unroll
                for (int bq = 0; bq < 4; ++bq) { const auto s = __builtin_amdgcn_permlane16_swap(__float_as_uint(part[bq]), __float_as_uint(part[bq]), false, false);
                    part[bq] = __uint_as_float(s[0]) + __uint_as_float(s[1]); }
                const auto r02 = __builtin_amdgcn_permlane32_swap(__float_as_uint(part[0]), __float_as_uint(part[2]), false, false);
                const auto r13 = __builtin_amdgcn_permlane32_swap(__float_as_uint(part[1]), __float_as_uint(part[3]), false, false);
                const float scA = __uint_as_float((g4 & 1) ? r13[0] : r02[0]), scB = __uint_as_float((g4 & 1) ? r13[1] : r02[1]);
                if (lane + 64 * j <= tA) key[j] = fkey(scA);
                s_keyB[64 * j + lane] = (lane + 64 * j <= tB) ? fkey(scB) : 0u;
            }
        }
        int nselA = 0, nselB = 0;
#define DSA_SELECT(NJ) { \
            if (qi) { \
                asm volatile("s_waitcnt lgkmcnt(0)" ::: "memory"); \
                _Pragma("unroll") \
                for (int j = 0; j < NJ; ++j) key[j] = (j < nj) ? s_keyB[64 * j + lane] : 0u; } \
            unsigned T = 0u; int need = 0; bool exact = false; \
            const bool all = (tq + 1 <= 256); \
            if (!all) {                                            \
                unsigned prefix = 0u; int r = 256;                 \
                _Pragma("unroll 1") \
                for (int pass = 0; pass < 4; ++pass) { \
                    const int sh = 24 - 8 * pass; \
                    *(LAS v4u*)(hist + 4 * lane) = (v4u){0u, 0u, 0u, 0u}; \
                    _Pragma("unroll") \
                    for (int j = 0; j < NJ; ++j) { const unsigned k = key[j]; \
                        if (pass == 0 || (k >> (sh + 8)) == prefix) (void)__hip_atomic_fetch_add(hist + ((k >> sh) & 255u), 1u, __ATOMIC_RELAXED, __HIP_MEMORY_SCOPE_WORKGROUP); } \
                    const v4u h = *(const LAS v4u*)(hist + 4 * lane);                \
                    const unsigned inc = wave_incl_scan_u32(h.x + h.y + h.z + h.w); \
                    const unsigned U = (unsigned)__builtin_amdgcn_readlane((int)inc, 63) - inc;     \
                    const unsigned s3 = U + h.w, s2 = s3 + h.z, s1 = s2 + h.y, s0 = s1 + h.x;       \
                    const unsigned ur = (unsigned)r; \
                    const int Lh = 63 - __clzll(__ballot(s0 >= ur));                   \
                    const int isel = (s3 >= ur) ? 3 : ((s2 >= ur) ? 2 : ((s1 >= ur) ? 1 : 0)); \
                    const unsigned hsel = isel == 3 ? h.w : (isel == 2 ? h.z : (isel == 1 ? h.y : h.x)), ssel = isel == 3 ? s3 : (isel == 2 ? s2 : (isel == 1 ? s1 : s0)); \
                    const unsigned dL = 4u * (unsigned)Lh + (unsigned)__builtin_amdgcn_readlane(isel, Lh); \
                    const unsigned hL = (unsigned)__builtin_amdgcn_readlane((int)hsel, Lh), sL = (unsigned)__builtin_amdgcn_readlane((int)ssel, Lh); \
                    prefix = (prefix << 8) | dL; \
                    r -= (int)(sL - hL);                                               \
                    T = prefix << sh; \
                    if ((int)hL == r) { exact = true; break; }                         \
                } \
                if (!exact) need = r;                                                  \
            } \
            int running = 0, eqrun = 0; \
            const unsigned long long lt = (1ull << lane) - 1ull; \
            if (all) {                                             \
                _Pragma("unroll") \
                for (int j = 0; j < NJ; ++j) { \
                    const int s = lane + 64 * j; \
                    const bool take = (s <= tq); \
                    const unsigned long long mt = __ballot(take); \
                    const int pos = running + __popcll(mt & lt); \
                    if (take) selp[pos] = s; \
                    running += __popcll(mt); \
                } \
            } else if (exact) {                                    \
                _Pragma("unroll") \
                for (int j = 0; j < NJ; ++j) { \
                    const bool take = key[j] >= T; \
                    const unsigned long long mt = __ballot(take); \
                    const int pos = running + __popcll(mt & lt); \
                    if (take) selp[pos] = lane + 64 * j; \
                    running += __popcll(mt); \
                } \
            } else \
            _Pragma("unroll") \
            for (int j = 0; j < NJ; ++j) { \
                const int s = lane + 64 * j; \
                const bool valid = (s <= tq); \
                const bool is_eq = valid && !all && key[j] == T; \
                const unsigned long long meq = __ballot(is_eq); \
                const int rank_eq = eqrun + __popcll(meq & lt); \
                const bool take = valid && (all || (exact ? key[j] >= T : (key[j] > T || (is_eq && rank_eq < need)))); \
                const unsigned long long mt = __ballot(take); \
                const int pos = running + __popcll(mt & lt); \
                if (take) selp[pos] = s; \
                running += __popcll(mt); eqrun += __popcll(meq); \
            } \
            if (qi) nselB = running; else nselA = running; }
#pragma unroll 1
        for (int qi = 0; qi < 2; ++qi) {
            const int tq = qi ? tB : tA; LAS int* selp = qi ? s_selB : s_sel;
            if (nj <= 16) { if (nj <= 8) { if (nj <= 4) DSA_SELECT(4) else DSA_SELECT(8) } else { if (nj <= 12) DSA_SELECT(12) else DSA_SELECT(16) } }
            else { if (nj <= 24) { if (nj <= 20) DSA_SELECT(20) else DSA_SELECT(24) } else { if (nj <= 28) DSA_SELECT(28) else DSA_SELECT(32) } }
        }
#undef DSA_SELECT
#pragma unroll 1
        for (int qi = 0; qi < 2; ++qi) {
            const int tq = qi ? tB : tA, rowq = qi ? rowB : rowA, nselq = qi ? nselB : nselA; LAS int* selp = qi ? s_selB : s_sel;
        LDS_WAIT(); asm volatile("" ::: "memory");
            const int grow = lane >> 4, gch = lane & 15;
            const char* ckb = (const char*)(CKVN + (size_t)bb * S * 128);
            v4u nx[8];
#define ATT_GATHER(JP) { int kk[8]; _Pragma("unroll") for (int i = 0; i < 8; ++i) kk[i] = selp[(32 * (JP) + 4 * i + grow) & 255]; \
                if (32 * ((JP) + 1) > nselq) { _Pragma("unroll") for (int i = 0; i < 8; ++i) kk[i] = (32 * (JP) + 4 * i + grow < nselq) ? kk[i] : 0; }     \
                _Pragma("unroll") for (int i = 0; i < 8; ++i) nx[i] = *(const GAS v4u*)(ckb + ((unsigned)kk[i] * 256u + (unsigned)gch * 16u)); }
            ATT_GATHER(0)
            bf16x8 qB[4]; float ss = 0.f;
#pragma unroll
            for (int s4 = 0; s4 < 4; ++s4) { v4u q4 = (v4u){0u, 0u, 0u, 0u};
                if (m16 < 8) q4 = *(const GAS v4u*)(QLAT + (size_t)rowq * 1024 + m16 * 128 + 32 * s4 + 8 * g4);
                qB[s4] = __builtin_bit_cast(bf16x8, q4);
                const float a0 = __uint_as_float(q4.x << 16), a1 = __uint_as_float(q4.x & 0xffff0000u), a2 = __uint_as_float(q4.y << 16), a3 = __uint_as_float(q4.y & 0xffff0000u),
                            a4 = __uint_as_float(q4.z << 16), a5 = __uint_as_float(q4.z & 0xffff0000u), a6 = __uint_as_float(q4.w << 16), a7 = __uint_as_float(q4.w & 0xffff0000u);
                ss += (a0 * a0 + a1 * a1) + (a2 * a2 + a3 * a3) + (a4 * a4 + a5 * a5) + (a6 * a6 + a7 * a7); }
            s_red[lane] = ss; LDS_WAIT(); asm volatile("" ::: "memory");
            const float mh = sqrtf(s_red[m16] + s_red[m16 + 16] + s_red[m16 + 32] + s_red[m16 + 48]) * BKV + bmax;
            LDS_WAIT(); asm volatile("" ::: "memory");
            f32x4 O[9];
#pragma unroll
            for (int ct = 0; ct < 9; ++ct) O[ct] = (f32x4){0.f, 0.f, 0.f, 0.f};
            const int npr = (nselq + 31) >> 5;
#pragma unroll 1
            for (int jp = 0; jp < npr; ++jp) {
#pragma unroll
                for (int i = 0; i < 8; ++i) *(LAS v4u*)(img + offb2(4 * i + grow, gch)) = nx[i];
                if (jp + 1 < npr) ATT_GATHER(jp + 1)
                f32x4 pr[2];
#pragma unroll
                for (int hb = 0; hb < 2; ++hb) {
                    f32x4 a = (f32x4){-mh, -mh, -mh, -mh};
#pragma unroll
                    for (int s4 = 0; s4 < 4; ++s4) a = MFMA16(frag_row2(img, 16 * hb, s4, lane), qB[s4], a);
                    pr[hb] = a; }
#pragma unroll
                for (int hb = 0; hb < 2; ++hb) { const int sl0 = 32 * jp + 16 * hb + 4 * g4;
                    const v4u kr4 = *(const LAS v4u*)(selp + sl0);
#pragma unroll
                    for (int r = 0; r < 4; ++r) { const int dd = min(max(tq - (int)kr4[r], 0), 127);
                        pr[hb][r] = __builtin_amdgcn_exp2f(fmaf(pr[hb][r], 1.4426950408889634f, s_bd[dd * 8 + hd])); }
                    if (32 * (jp + 1) > nselq) {
#pragma unroll
                        for (int r = 0; r < 4; ++r) pr[hb][r] = (sl0 + r < nselq) ? pr[hb][r] : 0.f; } }
                const bf16x8 pf = pack_acc2(pr[0], pr[1]);
                asm volatile("s_waitcnt lgkmcnt(0)" ::: "memory");
                bf16x8 vf[8];
#pragma unroll
                for (int ct = 0; ct < 8; ++ct) vf[ct] = frag_tr2(img, 0, ct, lane);
                O[8] = MFMA16(pf, ones, O[8]);
#pragma unroll
                for (int ct = 0; ct < 8; ++ct) O[ct] = MFMA16(pf, vf[ct], O[ct]);
                asm volatile("s_waitcnt lgkmcnt(0)" ::: "memory");
            }
            if (g4 < 2) {
#pragma unroll
                for (int r = 0; r < 4; ++r) { const float inv = 1.f / O[8][r];
#pragma unroll
                    for (int ct = 0; ct < 8; ++ct) *(LAS bf16*)(s_out + (4 * g4 + r) * 256 + (16 * ct + m16) * 2) = (bf16)f2bf(O[ct][r] * inv); } }
            LDS_WAIT(); asm volatile("" ::: "memory");
#pragma unroll
            for (int i = 0; i < 2; ++i) { const int n = lane + 64 * i; *(GAS v4u*)(QLAT + (size_t)rowq * 1024 + n * 8) = *(LAS v4u*)(s_out + n * 16); }
            LDS_WAIT(); asm volatile("" ::: "memory");
        }
    }
}
__device__ __forceinline__ void final_norm(Frame& F) {
    const int gw = F.vcu * NWAVES + F.wave, NGW = F.G * NWAVES, lane = (opaque((int)threadIdx.x) & 63);
    const pg8::ssq_t ssq = ssq_arr(F, 12); const float* g = ain(2);
    f32x4 gv[4];
#pragma unroll
    for (int j = 0; j < 4; ++j) gv[j] = ((const f32x4*)g)[lane + 64 * j];
    for (int m0 = gw; m0 < M; m0 += 4 * NGW) {
        unsigned long long q[4][4]; float r[4];
#pragma unroll
        for (int i = 0; i < 4; ++i) { const int m = m0 + i * NGW; const GAS unsigned long long* xi = (const GAS unsigned long long*)(wsb(F, WS_XB) + (size_t)m * D) + lane;
#pragma unroll
            for (int j = 0; j < 4; ++j) q[i][j] = xi[64 * j];
            r[i] = rsqrtf(pg8::sget(ssq, m) * (1.f / 1024.f) + EPSN); }
#pragma unroll
        for (int i = 0; i < 4; ++i) { const int m = m0 + i * NGW; GAS f32x4* xo = (GAS f32x4*)(aout() + (size_t)m * D) + lane;
#pragma unroll
            for (int j = 0; j < 4; ++j) { const unsigned a = (unsigned)q[i][j], b = (unsigned)(q[i][j] >> 32);
                f32x4 v = (f32x4){__uint_as_float(a << 16), __uint_as_float(a & 0xffff0000u), __uint_as_float(b << 16), __uint_as_float(b & 0xffff0000u)}; v = v * r[i] * gv[j]; xo[64 * j] = v; } }
    }
}

__global__ void __launch_bounds__(NWAVES * 64, 2) hybrid_fwd(Args args) {
    extern __shared__ __attribute__((aligned(16))) unsigned char lds[];
    Frame F;
    F.lds = (LAS unsigned char*)lds;
        F.wave = __builtin_amdgcn_readfirstlane((int)threadIdx.x >> 6);
    F.G = gridDim.x; { const int bx = blockIdx.x; F.vcu = (F.G % 8 == 0) ? (bx % 8) * (F.G / 8) + bx / 8 : bx; }
    F.ws = aws();
    ASSUME_GLOBAL(F.ws);
    for (int u = threadIdx.x; u < (LDS_BYTES - LDSCTL_OFF) / 4; u += NWAVES * 64) ((LAS unsigned*)(F.lds + LDSCTL_OFF))[u] = 0u;
    __syncthreads();
    if (!MK_PER_PHASE) (void)xcd_barrier_post((unsigned*)((gu32*)(F.ws + WS_CTL) + CW_BAR), (volatile LAS unsigned*)(F.lds + MISC_OFF) + 8);
#ifdef PROBE_PHASE
    unsigned long long probe_acc = 0ull, probe_t0 = 0ull;
#define PROBE_BEGIN(k) do { if ((k) == PROBE_PHASE) probe_t0 = __builtin_amdgcn_s_memrealtime(); } while (0)
#define PROBE_END(k) do { if ((k) == PROBE_PHASE) probe_acc += __builtin_amdgcn_s_memrealtime() - probe_t0; } while (0)
#else
#define PROBE_BEGIN(k) do {} while (0)
#define PROBE_END(k) do {} while (0)
#endif
#define IN(k) (aint(216) <= (k) && (k) < aint(220))
#define GRID_BAR(k) do { if (IN(k) && IN((k) + 1)) { XcdBarrier bar_; { unsigned char* bw_ = F.ws; asm volatile("" : "+s"(bw_)); bar_.bar = (unsigned*)((gu32*)(bw_ + WS_CTL) + CW_BAR); } bar_.x = xb_xcc_id(); bar_.st = (volatile LAS unsigned*)(F.lds + MISC_OFF) + 8; xcd_barrier(bar_); } } while (0)

    PROBE_BEGIN(7); if (IN(0)) { p0_prologue(F); GRID_BAR(0); } PROBE_END(7);

    for (int l = 0; l < 2; ++l) {
        const int pb = 1 + 7 * l;
#define WL(off) ((const bf16*)(F.ws + WS_W + (size_t)lq * W_LAYER + (off)))
        if (IN(pb + 0) && PH_ON(0)) { PROBE_BEGIN(0); int lq = l; asm volatile("" : "+s"(lq));
            pg8::Gemm g{wsb(F, WS_XB), WL(W_IN), M, 4096, 1024}; pg8::StaticOrder So; So.init(M, 4096, F.G, opaque_s((int)blockIdx.x));
            pg8::EpiG1 E{F.ws, lq, ain(6) + lq * 4, ain(7) + lq * 4};
            pg8::gemm_phase<pg8::EpiG1, pg8::StaticOrder, true, true>(F.lds + RING_OFF, g, So, E);
            GRID_BAR(pb + 0); PROBE_END(0);
        }
        if (IN(pb + 1) && PH_ON(1)) { PROBE_BEGIN(1); int lq = l; asm volatile("" : "+s"(lq));
            p2_norms(F, lq);
            pg8::Gemm g{wsb(F, WS_CQ), WL(W_Q2), M, 1536, 256}; pg8::StaticOrder So; So.init(M, 1536, F.G, opaque_s((int)blockIdx.x));
            pg8::EpiQ2 E{F.ws, lq};
            pg8::gemm_phase<pg8::EpiQ2, pg8::StaticOrder, true, true>(F.lds + RING_OFF, g, So, E);
            GRID_BAR(pb + 1); PROBE_END(1);
        }
        if (IN(pb + 2) && PH_ON(2)) { PROBE_BEGIN(2); int lq = l; asm volatile("" : "+s"(lq));
            if ((F.vcu & 3) == 0) { const int u = F.vcu >> 2; mlstm_unit(F, lq, u >> 2, u & 3); }
            else if ((F.vcu & 3) == 1) { const int u = F.vcu >> 2; retention_unit(F, lq, u >> 2, u & 3); }
            dsa_phase(F, lq);
            GRID_BAR(pb + 2); PROBE_END(2);
        }
        if (IN(pb + 3) && PH_ON(3)) { PROBE_BEGIN(3); int lq = l; asm volatile("" : "+s"(lq));
            for (int br = 0; br < 3; ++br) {
                {
                    pg8::Gemm g{wsb(F, WS_XB), WL(W_G) + (size_t)br * 1024 * 1024, M, 1024, 1024}; pg8::StaticOrder So; So.init(M, 1024, F.G, opaque_s((int)blockIdx.x));
                    pg8::EpiGate E{F.ws, lq};
                    pg8::gemm_phase<pg8::EpiGate, pg8::StaticOrder, true, true>(F.lds + RING_OFF, g, So, E);
                }
                {
                    const bf16* A = wsb(F, br == 0 ? WS_MV : (br == 1 ? WS_QLAT : WS_RV));
                    const bf16* Bt = WL(br == 0 ? W_PM : (br == 1 ? W_AV : W_PR));
                    pg8::Gemm g{A, Bt, M, 1024, br == 1 ? 1024 : 512}; pg8::StaticOrder So; So.init(M, 1024, F.G, opaque_s((int)blockIdx.x));
                    pg8::EpiBr E{F.ws, br};
                    pg8::gemm_phase<pg8::EpiBr, pg8::StaticOrder, true, true>(F.lds + RING_OFF, g, So, E);
                }
            }
            GRID_BAR(pb + 3); PROBE_END(3);
        }
        if (IN(pb + 4) && PH_ON(4)) { PROBE_BEGIN(4); int lq = l; asm volatile("" : "+s"(lq));
            pg8::Gemm g{wsb(F, WS_Y), WL(W_OUT), M, 1024, 1024}; pg8::StaticOrder So; So.init(M, 1024, F.G, opaque_s((int)blockIdx.x));
            pg8::EpiRes E{F.ws, lq * 6 + 1};
            pg8::gemm_phase<pg8::EpiRes, pg8::StaticOrder, true, true>(F.lds + RING_OFF, g, So, E);
            GRID_BAR(pb + 4); PROBE_END(4);
        }
        if (IN(pb + 5) && PH_ON(5)) { PROBE_BEGIN(5); int lq = l; asm volatile("" : "+s"(lq));
            pg8::Gemm g{wsb(F, WS_XB), WL(W_GU), M, 5632, 1024}; pg8::StaticOrder So; So.init(M, 5632, F.G, opaque_s((int)blockIdx.x));
            pg8::EpiUp E{F.ws, lq};
            pg8::gemm_phase<pg8::EpiUp, pg8::StaticOrder, true, true>(F.lds + RING_OFF, g, So, E);
            GRID_BAR(pb + 5); PROBE_END(5);
        }
        if (IN(pb + 6) && PH_ON(6)) { PROBE_BEGIN(6); int lq = l; asm volatile("" : "+s"(lq));
            pg8::Gemm g{wsb(F, WS_HID), WL(W_DN), M, 1024, 2816}; pg8::StaticOrder So; So.init(M, 1024, F.G, opaque_s((int)blockIdx.x));
            pg8::EpiRes E{F.ws, lq == 0 ? 6 : 12};
            pg8::gemm_phase<pg8::EpiRes, pg8::StaticOrder, true, true>(F.lds + RING_OFF, g, So, E);
            GRID_BAR(pb + 6); PROBE_END(6);
        }
#undef WL
    }
    if (IN(15)) final_norm(F);
#ifdef PROBE_PHASE
    { const unsigned long long t1 = __builtin_amdgcn_s_memrealtime(); while (__builtin_amdgcn_s_memrealtime() - t1 < probe_acc) __builtin_amdgcn_s_sleep(8); }
#endif
#undef IN
#undef GRID_BAR
}

extern "C" void kernel_launch(void* const* d_in, const int* in_sizes, int n_in, void* d_out, int out_size, void* d_ws, size_t ws_size, hipStream_t stream) {
    static int grid = 0;
    if (grid == 0) {
        if (n_in != 25 || out_size != M * D || ws_size < WS_END) { fprintf(stderr, "kernel_launch: unexpected shapes / workspace (%d inputs, out %d, ws %zu)\n", n_in, out_size, ws_size); grid = -1; return; }
        int dev = 0, cus = 0, per_cu = 0;
        if (hipGetDevice(&dev) != hipSuccess || hipDeviceGetAttribute(&cus, hipDeviceAttributeMultiprocessorCount, dev) != hipSuccess) { grid = -1; return; }
        if (hipFuncSetAttribute((const void*)hybrid_fwd, hipFuncAttributeMaxDynamicSharedMemorySize, LDS_BYTES) != hipSuccess) { grid = -1; return; }
        if (hipOccupancyMaxActiveBlocksPerMultiprocessor(&per_cu, (const void*)hybrid_fwd, NWAVES * 64, LDS_BYTES) != hipSuccess || per_cu < 1) { fprintf(stderr, "kernel_launch: occupancy query says %d\n", per_cu); }
        (void)hipGetLastError();
        grid = cus;
    }
    if (grid < 0) return;
    if (hipMemsetAsync((char*)d_ws + WS_CTL, 0, CTL_ZERO_BYTES, stream) != hipSuccess) return;
    Args a{};
    for (int i = 0; i < 25; ++i) a.in[i] = (const float*)d_in[i];
    a.out = (float*)d_out; a.ws = (unsigned char*)d_ws;
#if MK_PER_PHASE
    for (int p = 0; p < N_PHASES; ++p) { a.ph_lo = p; a.ph_hi = p + 1; hipLaunchKernelGGL(hybrid_fwd, dim3(grid), dim3(NWAVES * 64), LDS_BYTES, stream, a); }
#else
    a.ph_lo = 0; a.ph_hi = N_PHASES;
    hipLaunchKernelGGL(hybrid_fwd, dim3(grid), dim3(NWAVES * 64), LDS_BYTES, stream, a);
#endif
}
```

```cpp
#include <hip/hip_runtime.h>
#include <cstdio>
#include <cstdint>
#include <math.h>
#if defined(__HIP_DEVICE_COMPILE__)
#define ASSUME_GLOBAL(p) __builtin_assume(!__builtin_amdgcn_is_shared(p) && !__builtin_amdgcn_is_private(p))
#else
#define ASSUME_GLOBAL(p) ((void)0)
#endif
constexpr int NWAVES = 8;
constexpr int D = 1024, NB = 16, S = 2048, M = NB * S, DIN = 7120, DFF = 2816;
constexpr int Z_MQ = 0, Z_MK = 256, Z_MV = 512, Z_MI = 1024, Z_MF = 1028, Z_MO = 1032, Z_CQ = 1544, Z_KIDX = 1800, Z_WIDX = 1864,
              Z_CKV = 1872, Z_RQ = 2000, Z_RK = 2512, Z_RV = 3024, Z_RG = 3536, Z_GM = 4048;
constexpr float EPSN = 1e-6f;
#ifndef MK_PER_PHASE
#define MK_PER_PHASE 0
#endif
#ifndef ONLY_PHASE
#define ONLY_PHASE -1
#endif
#define PH_ON(k) (ONLY_PHASE < 0 || ONLY_PHASE == (k))
constexpr int N_PHASES = 16;

constexpr size_t MiB = 1u << 20;
constexpr size_t WS_CTL = 0, CTL_ZERO_BYTES = 4 * MiB;
constexpr size_t WS_ROT = 79 * MiB;
constexpr size_t WS_W = 4 * MiB;
constexpr size_t W_IN = 0, W_G = W_IN + (size_t)4096 * 1024 * 2, W_Q2 = W_G + (size_t)3072 * 1024 * 2, W_PM = W_Q2 + (size_t)1536 * 256 * 2, W_PR = W_PM + (size_t)1024 * 512 * 2,
                 W_AV = W_PR + (size_t)1024 * 512 * 2, W_OUT = W_AV + (size_t)1024 * 1024 * 2, W_GU = W_OUT + (size_t)1024 * 1024 * 2, W_DN = W_GU + (size_t)5632 * 1024 * 2,
                 W_LAYER = W_DN + (size_t)1024 * 2816 * 2;
static_assert(WS_W + 2 * W_LAYER <= 79 * MiB, "weights fit");
constexpr size_t WS_XB = 80 * MiB, WS_QLAT = 144 * MiB, WS_MV = 208 * MiB, WS_RV = 240 * MiB, WS_QIDX = 272 * MiB, WS_CKVN = 304 * MiB, WS_KIDXN = 312 * MiB, WS_MQK = 316 * MiB,
                 WS_MO = 348 * MiB, WS_RG = 380 * MiB, WS_RQ = 412 * MiB, WS_RK = 444 * MiB, WS_CQ = 476 * MiB, WS_CKV = 492 * MiB, WS_KIDX = 500 * MiB, WS_MIF = 504 * MiB, WS_WIDX = 505 * MiB,
                 WS_END = 506 * MiB;
constexpr size_t WS_YACC = 272 * MiB, WS_G8 = 336 * MiB, WS_Y = 400 * MiB;
constexpr size_t WS_HID = 144 * MiB;
constexpr int CW_TMO = 0, CW_BAR = 4096;
constexpr size_t SSQ_OFF = 64 * 1024, SSQ_STRIDE = 256 * 1024;
static_assert(SSQ_OFF + 13 * SSQ_STRIDE <= CTL_ZERO_BYTES, "ssq arrays inside the memset region");
constexpr int RING_OFF = 0, RING_BYTES = 131072, LDSCTL_OFF = RING_BYTES, MISC_OFF = LDSCTL_OFF + 320, LDS_BYTES = 147456;

namespace pg8 {
#define PG8_LAS __attribute__((address_space(3)))
typedef unsigned short bf16_t;
typedef short bf16x8 __attribute__((ext_vector_type(8)));
typedef float f32x4 __attribute__((ext_vector_type(4)));
typedef unsigned u32x4 __attribute__((ext_vector_type(4)));
typedef unsigned u32x2 __attribute__((ext_vector_type(2)));
constexpr int BM = 256, BK = 64, HALF = 128, HTB = HALF * BK * 2  , STAGE_BYTES = 8 * HTB, NXCD = 8, WGM = 8;

__host__ __device__ __forceinline__ int lds_byte(int r, int c) { const int st = (r >> 4) * 2 + (c >> 5), rr = r & 15, cc = c & 31, ob = rr * 64 + cc * 2; return st * 1024 + (ob ^ (((ob >> 9) & 1) << 5)); }
__host__ __device__ __forceinline__ void stage_rc(int b, int& R, int& C) { const int st = b / 1024, sb = b % 1024, swz = sb ^ (((sb >> 9) & 1) << 5); R = (st >> 1) * 16 + swz / 64; C = (st & 1) * 32 + (swz % 64) / 2; }
__host__ __device__ __forceinline__ int perm32(int rho) { const int n = rho >> 4, i = rho & 15; return 8 * (i >> 2) + 4 * n + (i & 3); }

struct Unit { int pm, pn; };
struct Gemm { const bf16_t* A; const bf16_t* Bt; int M, N, K; };

struct StaticOrder {
    int nM, nN, nwg, G, c;
    __host__ __device__ void init(int M, int N, int G_, int c_) { nM = M / BM; nN = N / BM; nwg = nM * nN; G = G_; c = c_; }
    __host__ __device__ bool next(int i, Unit& u) const {
        const long L = (long)i * G + c; if (L >= nwg) return false;
        int wgid = (int)L; { const int q = nwg / NXCD, r = nwg % NXCD, xcd = wgid % NXCD, off = wgid / NXCD; wgid = (xcd < r ? xcd * (q + 1) : r * (q + 1) + (xcd - r) * q) + off; }
        const int nig = WGM * nN, gid = wgid / nig, fm = gid * WGM, gsz = (nM - fm) < WGM ? (nM - fm) : WGM;
        u.pm = fm + ((wgid % nig) % gsz); u.pn = (wgid % nig) / gsz; return true;
    }
    __device__ __forceinline__ void a_ready(const Unit&) const {}
    __device__ __forceinline__ void done(const Unit&) const {}
};
__device__ __forceinline__ unsigned cvt_pk_bf16(float lo, float hi) { unsigned r; asm volatile("v_cvt_pk_bf16_f32 %0, %1, %2" : "=v"(r) : "v"(lo), "v"(hi)); return r; }
constexpr float NEPS = 1e-6f;
__device__ __forceinline__ u32x4 pack8(const f32x4& a, const f32x4& b) { u32x4 w; w.x = cvt_pk_bf16(a[0], a[1]); w.y = cvt_pk_bf16(a[2], a[3]); w.z = cvt_pk_bf16(b[0], b[1]); w.w = cvt_pk_bf16(b[2], b[3]); return w; }
__device__ __forceinline__ float sum4sq(const f32x4& a) { return (a[0] * a[0] + a[1] * a[1]) + (a[2] * a[2] + a[3] * a[3]); }
__device__ __forceinline__ float sum4(const f32x4& a) { return (a[0] + a[1]) + (a[2] + a[3]); }
__device__ __forceinline__ float red_fq(float s) { s += __shfl_xor(s, 16); s += __shfl_xor(s, 32); return s; }
__device__ __forceinline__ float fsigmoid(float x) { return __builtin_amdgcn_rcpf(1.f + __expf(-x)); }
typedef float pk_f32x2 __attribute__((ext_vector_type(2)));
typedef __bf16 pk_bf16x2 __attribute__((ext_vector_type(2)));
__device__ __forceinline__ unsigned cvt_pk_bf16v(float a, float b) { const pk_f32x2 v = {a, b}; return __builtin_bit_cast(unsigned, __builtin_convertvector(v, pk_bf16x2)); }
__device__ __forceinline__ u32x4 pack8v(const f32x4& a, const f32x4& b) { u32x4 w; w.x = cvt_pk_bf16v(a[0], a[1]); w.y = cvt_pk_bf16v(a[2], a[3]); w.z = cvt_pk_bf16v(b[0], b[1]); w.w = cvt_pk_bf16v(b[2], b[3]); return w; }
__device__ __forceinline__ f32x4 u8x4f(unsigned a) { return (f32x4){(float)(a & 0xffu), (float)((a >> 8) & 0xffu), (float)((a >> 16) & 0xffu), (float)(a >> 24)}; }
__device__ __forceinline__ f32x4 bf4_lo(unsigned a, unsigned b) { return (f32x4){__uint_as_float(a << 16), __uint_as_float(a & 0xffff0000u), __uint_as_float(b << 16), __uint_as_float(b & 0xffff0000u)}; }
__device__ __forceinline__ unsigned char* opq(unsigned char* p) { asm volatile("" : "+s"(p)); ASSUME_GLOBAL(p); return p; }
#define PG8_GAS __attribute__((address_space(1)))
typedef PG8_GAS long long* ssq_t;
__device__ __forceinline__ ssq_t ssqp(unsigned char* w, int k) { return (ssq_t)(w + WS_CTL + SSQ_OFF + (size_t)k * SSQ_STRIDE); }
__device__ __forceinline__ void gadd(ssq_t p, float v) { (void)__hip_atomic_fetch_add((PG8_GAS unsigned long long*)p, (unsigned long long)__float2ll_rn(v * 1048576.f), __ATOMIC_RELAXED, __HIP_MEMORY_SCOPE_AGENT); }
__device__ __forceinline__ float sget(ssq_t p, int row) { return (float)p[row] * (1.f / 1048576.f); }
#define EPI_ROWCOL(colexpr) int row0 = u.pm * BM + wr * 64 + fr, cl = (colexpr); asm volatile("" : "+v"(row0), "+v"(cl)); unsigned char* const w = opq(ws)

struct EpiG1 {
    static constexpr bool PERM = true, AFTER_DRAIN = false;
    unsigned char* ws; int l; const float* ibias; const float* fbias;
    __device__ __forceinline__ void operator()(const f32x4 (&acc)[2][2][4][2], const Unit& u, int wr, int wc, int fr, int fq) const {
        const int pn = u.pn; EPI_ROWCOL(wc * 32 + 8 * fq);
        const ssq_t ssq1 = ssqp(w, l * 6 + 0);
        if (pn == 7) {
            bf16_t* CKV = (bf16_t*)(w + WS_CKV); bf16_t* KIDX = (bf16_t*)(w + WS_KIDX); float* WIDX = (float*)(w + WS_WIDX); float* MIF = (float*)(w + WS_MIF);
            const ssq_t ssq_ckv = ssqp(w, l * 6 + 3); const ssq_t sum_kidx = ssqp(w, l * 6 + 4); const ssq_t ssq_kidx = ssqp(w, l * 6 + 5);
            f32x4 ib = (f32x4){0.f, 0.f, 0.f, 0.f}, fb = ib;
            if (wc == 2 && fq == 1) { ib = *(const PG8_GAS f32x4*)ibias; fb = *(const PG8_GAS f32x4*)fbias; }
#pragma unroll
            for (int ai = 0; ai < 2; ++ai)
#pragma unroll
                for (int m = 0; m < 4; ++m) {
                    const int row = row0 + ai * HALF + m * 16;
                    const float rstd = rsqrtf(sget(ssq1, row) * (1.f / 1024.f) + NEPS);
                    const f32x4 a0 = acc[ai][0][m][0] * rstd, a1 = acc[ai][0][m][1] * rstd, b0 = acc[ai][1][m][0] * rstd, b1 = acc[ai][1][m][1] * rstd;
                    *(PG8_GAS u32x4*)(CKV + (size_t)row * 128 + cl) = pack8(a0, a1);
                    const float ss = red_fq(sum4sq(a0) + sum4sq(a1));
                    if (fq == 0) gadd(ssq_ckv + row, ss);
                    if (wc < 2) {
                        *(PG8_GAS u32x4*)(KIDX + (size_t)row * 64 + cl) = pack8(b0, b1);
                        const float s1 = red_fq(sum4(b0) + sum4(b1)), s2 = red_fq(sum4sq(b0) + sum4sq(b1));
                        if (fq == 0) { gadd(sum_kidx + row, s1); gadd(ssq_kidx + row, s2); }
                    } else if (wc == 2) {
                        if (fq == 0) { *(PG8_GAS f32x4*)(WIDX + (size_t)row * 8) = b0 * 0.04419417382415922f; *(PG8_GAS f32x4*)(WIDX + (size_t)row * 8 + 4) = b1 * 0.04419417382415922f; }
                        if (fq == 1) { *(PG8_GAS f32x4*)(MIF + (size_t)row * 8) = b0 + ib; *(PG8_GAS f32x4*)(MIF + (size_t)row * 8 + 4) = b1 + fb; }
                    }
                }
            return;
        }
        if (pn >= 8 && pn < 12) {
            const bool isk = pn >= 10; bf16_t* dst = (bf16_t*)(w + (isk ? WS_RK : WS_RQ)); const int coff = 256 * ((pn - 8) & 1);
            const float* rot = (const float*)(w + WS_ROT);
            const float sc = isk ? 0.08838834764831845f : 1.f; const int i0 = 4 * (4 * wc + fq);
#pragma unroll
            for (int ai = 0; ai < 2; ++ai)
#pragma unroll
                for (int m = 0; m < 4; ++m) {
                    const int row = row0 + ai * HALF + m * 16, t = row & 2047;
                    const float rstd = rsqrtf(sget(ssq1, row) * (1.f / 1024.f) + NEPS) * sc;
                    const f32x4 cs = *(const PG8_GAS f32x4*)(rot + (size_t)t * 128 + i0), sn = *(const PG8_GAS f32x4*)(rot + (size_t)t * 128 + 64 + i0);
#pragma unroll
                    for (int bj = 0; bj < 2; ++bj) {
                        const f32x4 x1 = acc[ai][bj][m][0] * rstd, x2 = acc[ai][bj][m][1] * rstd;
                        const f32x4 o1 = x1 * cs - x2 * sn, o2 = x1 * sn + x2 * cs;
                        *(PG8_GAS u32x4*)(dst + (size_t)row * 512 + coff + bj * HALF + cl) = pack8(o1, o2);
                    }
                }
            return;
        }
        size_t boff; int ld = 512, coff;
        if (pn < 2) { boff = WS_MQK; coff = 256 * pn; } else if (pn < 4) { boff = WS_MV; coff = 256 * (pn - 2); } else if (pn < 6) { boff = WS_MO; coff = 256 * (pn - 4); }
        else if (pn == 6) { boff = WS_CQ; ld = 256; coff = 0; } else if (pn < 14) { boff = WS_RV; coff = 256 * (pn - 12); } else { boff = WS_RG; coff = 256 * (pn - 14); }
        bf16_t* base = (bf16_t*)(w + boff); const ssq_t ssq_cq = ssqp(w, l * 6 + 2);
#pragma unroll
        for (int ai = 0; ai < 2; ++ai)
#pragma unroll
            for (int m = 0; m < 4; ++m) {
                const int row = row0 + ai * HALF + m * 16;
                const float rstd = rsqrtf(sget(ssq1, row) * (1.f / 1024.f) + NEPS);
                float ss = 0.f;
#pragma unroll
                for (int bj = 0; bj < 2; ++bj) {
                    const f32x4 v0 = acc[ai][bj][m][0] * rstd, v1 = acc[ai][bj][m][1] * rstd;
                    *(PG8_GAS u32x4*)(base + (size_t)row * ld + coff + bj * HALF + cl) = pack8(v0, v1);
                    ss += sum4sq(v0) + sum4sq(v1);
                }
                if (pn == 6) { ss = red_fq(ss); if (fq == 0) gadd(ssq_cq + row, ss); }
            }
    }
};
struct EpiQ2 {
    static constexpr bool PERM = true, AFTER_DRAIN = false;
    unsigned char* ws; int l;
    __device__ __forceinline__ void operator()(const f32x4 (&acc)[2][2][4][2], const Unit& u, int wr, int wc, int fr, int fq) const {
        const int pn = u.pn; EPI_ROWCOL(wc * 32 + 8 * fq);
        const ssq_t ssq_cq = ssqp(w, l * 6 + 2);
        bf16_t* base = (bf16_t*)(w + (pn < 4 ? WS_QLAT : WS_QIDX)); const int ld = pn < 4 ? 1024 : 512, coff = pn < 4 ? 256 * pn : 256 * (pn - 4);
#pragma unroll
        for (int ai = 0; ai < 2; ++ai)
#pragma unroll
            for (int m = 0; m < 4; ++m) {
                const int row = row0 + ai * HALF + m * 16;
                const float rstd = rsqrtf(sget(ssq_cq, row) * (1.f / 256.f) + NEPS);
#pragma unroll
                for (int bj = 0; bj < 2; ++bj)
                    *(PG8_GAS u32x4*)(base + (size_t)row * ld + coff + bj * HALF + cl) = pack8(acc[ai][bj][m][0] * rstd, acc[ai][bj][m][1] * rstd);
            }
    }
};
struct EpiGate {
    static constexpr bool PERM = true, AFTER_DRAIN = false;
    unsigned char* ws; int l;
    __device__ __forceinline__ void operator()(const f32x4 (&acc)[2][2][4][2], const Unit& u, int wr, int wc, int fr, int fq) const {
        EPI_ROWCOL(u.pn * BM + wc * 32 + 8 * fq);
        const ssq_t ssq1 = ssqp(w, l * 6 + 0); unsigned char* G8 = w + WS_G8;
#pragma unroll
        for (int ai = 0; ai < 2; ++ai)
#pragma unroll
            for (int m = 0; m < 4; ++m) {
                const int row = row0 + ai * HALF + m * 16;
                const float rstd = rsqrtf(sget(ssq1, row) * (1.f / 1024.f) + NEPS);
#pragma unroll
                for (int bj = 0; bj < 2; ++bj) {
                    f32x4 v0 = acc[ai][bj][m][0] * rstd, v1 = acc[ai][bj][m][1] * rstd;
#pragma unroll
                    for (int j = 0; j < 4; ++j) { v0[j] = fsigmoid(v0[j]) * 255.f; v1[j] = fsigmoid(v1[j]) * 255.f; }
                    unsigned lo = 0u, hi = 0u;
                    lo = __builtin_amdgcn_cvt_pk_u8_f32(v0[0], 0, lo); lo = __builtin_amdgcn_cvt_pk_u8_f32(v0[1], 1, lo); lo = __builtin_amdgcn_cvt_pk_u8_f32(v0[2], 2, lo); lo = __builtin_amdgcn_cvt_pk_u8_f32(v0[3], 3, lo);
                    hi = __builtin_amdgcn_cvt_pk_u8_f32(v1[0], 0, hi); hi = __builtin_amdgcn_cvt_pk_u8_f32(v1[1], 1, hi); hi = __builtin_amdgcn_cvt_pk_u8_f32(v1[2], 2, hi); hi = __builtin_amdgcn_cvt_pk_u8_f32(v1[3], 3, hi);
                    *(PG8_GAS u32x2*)(G8 + (unsigned)(row * 1024 + cl + bj * HALF)) = (u32x2){lo, hi};
                }
            }
    }
};
struct EpiBr {
    static constexpr bool PERM = true, AFTER_DRAIN = false;
    unsigned char* ws; int mode;
    __device__ __forceinline__ void operator()(const f32x4 (&acc)[2][2][4][2], const Unit& u, int wr, int wc, int fr, int fq) const {
        EPI_ROWCOL(u.pn * BM + wc * 32 + 8 * fq);
        const unsigned char* G8 = w + WS_G8; bf16_t* Y = (bf16_t*)(w + WS_Y); bf16_t* YACC = (bf16_t*)(w + WS_YACC);
#pragma unroll
        for (int ai = 0; ai < 2; ++ai)
#pragma unroll
            for (int m = 0; m < 4; ++m) {
                const int row = row0 + ai * HALF + m * 16;
#pragma unroll
                for (int bj = 0; bj < 2; ++bj) {
                    const unsigned o = (unsigned)(row * 1024 + cl + bj * HALF), ob = 2u * o;
                    const u32x2 g = *(const PG8_GAS u32x2*)(G8 + o);
                    f32x4 v0 = acc[ai][bj][m][0] * (u8x4f(g.x) * (1.f / 255.f)), v1 = acc[ai][bj][m][1] * (u8x4f(g.y) * (1.f / 255.f));
                    if (mode != 0) { const u32x4 y = *(const PG8_GAS u32x4*)((const unsigned char*)YACC + ob); v0 += bf4_lo(y.x, y.y); v1 += bf4_lo(y.z, y.w); }
                    *(PG8_GAS u32x4*)((unsigned char*)(mode != 2 ? YACC : Y) + ob) = pack8(v0, v1);
                }
            }
    }
};
struct EpiRes {
    static constexpr bool PERM = true, AFTER_DRAIN = false;
    unsigned char* ws; int kss;
    __device__ __forceinline__ void operator()(const f32x4 (&acc)[2][2][4][2], const Unit& u, int wr, int wc, int fr, int fq) const {
        EPI_ROWCOL(u.pn * BM + wc * 32 + 8 * fq);
        bf16_t* XB = (bf16_t*)(w + WS_XB); const ssq_t ssq_next = ssqp(w, kss);
#pragma unroll
        for (int ai = 0; ai < 2; ++ai)
#pragma unroll
            for (int m = 0; m < 4; ++m) {
                const int row = row0 + ai * HALF + m * 16;
                float ss = 0.f;
#pragma unroll
                for (int bj = 0; bj < 2; ++bj) {
                    const unsigned ob = 2u * (unsigned)(row * 1024 + cl + bj * HALF);
                    const u32x4 xo = *(const PG8_GAS u32x4*)((const unsigned char*)XB + ob);
                    const f32x4 v0 = acc[ai][bj][m][0] + bf4_lo(xo.x, xo.y), v1 = acc[ai][bj][m][1] + bf4_lo(xo.z, xo.w);
                    *(PG8_GAS u32x4*)((unsigned char*)XB + ob) = pack8(v0, v1);
                    ss += sum4sq(v0) + sum4sq(v1);
                }
                ss = red_fq(ss); if (fq == 0) gadd(ssq_next + row, ss);
            }
    }
};
struct EpiUp {
    static constexpr bool PERM = true, AFTER_DRAIN = false;
    unsigned char* ws; int l;
    __device__ __forceinline__ void operator()(const f32x4 (&acc)[2][2][4][2], const Unit& u, int wr, int wc, int fr, int fq) const {
        EPI_ROWCOL(u.pn * HALF + wc * 32 + 8 * fq);
        const ssq_t ssq2 = ssqp(w, l * 6 + 1); bf16_t* HID = (bf16_t*)(w + WS_HID);
#pragma unroll
        for (int ai = 0; ai < 2; ++ai)
#pragma unroll
            for (int m = 0; m < 4; ++m) {
                const int row = row0 + ai * HALF + m * 16;
                const float rstd = rsqrtf(sget(ssq2, row) * (1.f / 1024.f) + NEPS);
                f32x4 h[2];
#pragma unroll
                for (int n = 0; n < 2; ++n) {
                    const f32x4 g = acc[ai][0][m][n] * rstd, up = acc[ai][1][m][n] * rstd;
#pragma unroll
                    for (int j = 0; j < 4; ++j) h[n][j] = g[j] * fsigmoid(g[j]) * up[j];
                }
                *(PG8_GAS u32x4*)((unsigned char*)HID + 2u * (unsigned)(row * 2816 + cl)) = pack8(h[0], h[1]);
            }
    }
};

template <class Epi, class Sched, bool ALIGN_EPI = false, bool SP2 = false>
__device__ __forceinline__ void gemm_phase(PG8_LAS unsigned char* lds, const Gemm g, const Sched& S, const Epi& E) {
    int tid_ = threadIdx.x; asm volatile("" : "+v"(tid_));
    const int tid = tid_, wid = __builtin_amdgcn_readfirstlane(tid >> 6), lane = tid & 63, wr = wid >> 2, wc = wid & 3, fr = lane & 15, fq = lane >> 4;
    int K_ = __builtin_amdgcn_readfirstlane(g.K); asm volatile("" : "+s"(K_));
    const int K = K_, nt = K / BK;
    unsigned voffA[2], voffB[2];
#pragma unroll
    for (int i = 0; i < 2; ++i) { int R, C; stage_rc(tid * 16 + i * 8192, R, C); const int Rb = Epi::PERM ? ((R & ~31) + perm32(R & 31)) : R;
        voffA[i] = (unsigned)(R * K + C) * 2u; voffB[i] = (unsigned)(Rb * K + C) * 2u; }
    const size_t kstep = (size_t)(BK * 2);
    const size_t hstep = (size_t)HALF * K * 2;
    const size_t tstep = 2 * hstep;
    const unsigned ldsw = (unsigned)wid * 1024u;
    const int aoff = lds_byte(wr * 64 + fr, fq * 8), boff = lds_byte(wc * 32 + fr, fq * 8);
#define PG8_SA(b, h) (((b) * 2 + (h)) * HTB)
#define PG8_SB(b, h) ((4 + (b) * 2 + (h)) * HTB)
#define PG8_STAGE(bufoff, gbase, voff) do { const char* sb_ = (const char*)(gbase); asm volatile("" : "+s"(sb_)); _Pragma("unroll") for (int _i = 0; _i < 2; ++_i) \
        __builtin_amdgcn_global_load_lds((const unsigned*)(sb_ + (voff)[_i]), (PG8_LAS unsigned*)(lds + (bufoff) + ldsw + _i * 8192), 16, 0, 0); } while (0)
#define PG8_LDA(dst, b, h) do { _Pragma("unroll") for (int m = 0; m < 4; ++m) _Pragma("unroll") for (int k = 0; k < 2; ++k) dst[m][k] = *(const PG8_LAS bf16x8*)(lds + PG8_SA(b, h) + aoff + m * 2048 + k * 1024); } while (0)
#define PG8_LDB(dst, b, h) do { _Pragma("unroll") for (int n = 0; n < 2; ++n) _Pragma("unroll") for (int k = 0; k < 2; ++k) dst[n][k] = *(const PG8_LAS bf16x8*)(lds + PG8_SB(b, h) + boff + n * 2048 + k * 1024); } while (0)
#define PG8_MMA(ai, bj, At, Bt) do { __builtin_amdgcn_s_setprio(1); _Pragma("unroll") for (int m = 0; m < 4; ++m) _Pragma("unroll") for (int n = 0; n < 2; ++n) _Pragma("unroll") for (int k = 0; k < 2; ++k) \
        acc[ai][bj][m][n] = __builtin_amdgcn_mfma_f32_16x16x32_bf16(Bt[n][k], At[m][k], acc[ai][bj][m][n], 0, 0, 0); __builtin_amdgcn_s_setprio(0); } while (0)
#define PG8_WAIT_V(n) asm volatile("s_waitcnt vmcnt(" #n ")" ::: "memory")
#define PG8_WAIT_L(n) asm volatile("s_waitcnt lgkmcnt(" #n ")" ::: "memory")
#define PG8_BAR __builtin_amdgcn_s_barrier()
#define PG8_SCHED __builtin_amdgcn_sched_barrier(0)
    Unit cur, nxt; int ui = 0;
    if (!S.next(0, cur)) return;
    f32x4 acc[2][2][4][2];
#pragma unroll
    for (int a = 0; a < 2; ++a)
#pragma unroll
        for (int b = 0; b < 2; ++b)
#pragma unroll
            for (int m = 0; m < 4; ++m)
#pragma unroll
                for (int n = 0; n < 2; ++n) acc[a][b][m][n] = (f32x4){0.f, 0.f, 0.f, 0.f};
    bf16x8 At[4][2], B0[2][2], B1[2][2];
    const char* cA = (const char*)g.A + (size_t)cur.pm * tstep; const char* cB = (const char*)g.Bt + (size_t)cur.pn * tstep;
    S.a_ready(cur);
    if constexpr (SP2) {
        PG8_STAGE(PG8_SB(0, 0), cB, voffB); PG8_STAGE(PG8_SB(0, 1), cB + hstep, voffB); PG8_STAGE(PG8_SA(0, 0), cA, voffA); PG8_STAGE(PG8_SA(0, 1), cA + hstep, voffA);
        if (wr == 1) PG8_BAR;
        PG8_WAIT_V(2); PG8_BAR;
        PG8_STAGE(PG8_SB(1, 0), cB + kstep, voffB); PG8_STAGE(PG8_SA(1, 0), cA + kstep, voffA); PG8_STAGE(PG8_SB(1, 1), cB + hstep + kstep, voffB);
        PG8_WAIT_V(6); PG8_BAR;
    } else {
        PG8_STAGE(PG8_SB(0, 0), cB, voffB); PG8_STAGE(PG8_SA(0, 0), cA, voffA); PG8_STAGE(PG8_SB(0, 1), cB + hstep, voffB); PG8_STAGE(PG8_SA(0, 1), cA + hstep, voffA);
        if (wr == 1) PG8_BAR;
        PG8_WAIT_V(4); PG8_BAR;
        PG8_STAGE(PG8_SB(1, 0), cB + kstep, voffB); PG8_STAGE(PG8_SA(1, 0), cA + kstep, voffA); PG8_STAGE(PG8_SB(1, 1), cB + hstep + kstep, voffB);
        PG8_WAIT_V(6); PG8_BAR;
    }
    for (;;) {
        const bool has_next = S.next(ui + 1, nxt);
        const char* nA = has_next ? (const char*)g.A + (size_t)nxt.pm * tstep : cA; const char* nB = has_next ? (const char*)g.Bt + (size_t)nxt.pn * tstep : cB;
        for (int t = 0; t < nt; t += 2) {
            asm volatile("" : "+v"(voffA[0]), "+v"(voffA[1]), "+v"(voffB[0]), "+v"(voffB[1]));
            const bool last = (t == nt - 2);
            const char* a1 = cA + (size_t)(t + 1) * kstep;
            const char* a2 = last ? nA : cA + (size_t)(t + 2) * kstep; const char* b2 = last ? nB : cB + (size_t)(t + 2) * kstep;
            const char* a3 = a2 + kstep; const char* b3 = b2 + kstep;
            if (last && has_next) S.a_ready(nxt);
            if constexpr (SP2) {
            PG8_LDB(B0, 0, 0); PG8_LDB(B1, 0, 1); PG8_SCHED; PG8_LDA(At, 0, 0); PG8_STAGE(PG8_SA(1, 1), a1 + hstep, voffA);
            PG8_WAIT_V(8); PG8_WAIT_L(0); PG8_BAR; PG8_MMA(0, 0, At, B0); PG8_MMA(0, 1, At, B1); PG8_BAR; PG8_SCHED;
            PG8_LDA(At, 0, 1); PG8_STAGE(PG8_SB(0, 0), b2, voffB); PG8_STAGE(PG8_SB(0, 1), b2 + hstep, voffB); PG8_STAGE(PG8_SA(0, 0), a2, voffA);
            PG8_WAIT_V(8); PG8_WAIT_L(0); PG8_BAR; PG8_MMA(1, 0, At, B0); PG8_MMA(1, 1, At, B1); PG8_BAR; PG8_SCHED;
            PG8_LDB(B0, 1, 0); PG8_LDB(B1, 1, 1); PG8_SCHED; PG8_LDA(At, 1, 0); PG8_STAGE(PG8_SA(0, 1), a2 + hstep, voffA);
            PG8_WAIT_V(8); PG8_WAIT_L(0); PG8_BAR; PG8_MMA(0, 0, At, B0); PG8_MMA(0, 1, At, B1); PG8_BAR; PG8_SCHED;
            PG8_LDA(At, 1, 1); PG8_STAGE(PG8_SB(1, 0), b3, voffB); PG8_STAGE(PG8_SB(1, 1), b3 + hstep, voffB); PG8_STAGE(PG8_SA(1, 0), a3, voffA);
            PG8_WAIT_V(8); PG8_WAIT_L(0); PG8_BAR; PG8_MMA(1, 0, At, B0); PG8_MMA(1, 1, At, B1); PG8_BAR; PG8_SCHED;
            } else {
            PG8_LDB(B0, 0, 0); PG8_SCHED; PG8_LDA(At, 0, 0); PG8_STAGE(PG8_SA(1, 1), a1 + hstep, voffA);
            PG8_WAIT_L(8); PG8_BAR; PG8_WAIT_L(0); PG8_MMA(0, 0, At, B0); PG8_BAR; PG8_SCHED;
            PG8_LDB(B1, 0, 1); PG8_STAGE(PG8_SB(0, 0), b2, voffB);
            PG8_BAR; PG8_WAIT_L(0); PG8_MMA(0, 1, At, B1); PG8_BAR;
            PG8_LDA(At, 0, 1); PG8_STAGE(PG8_SA(0, 0), a2, voffA);
            PG8_BAR; PG8_WAIT_L(0); PG8_MMA(1, 0, At, B0); PG8_BAR; PG8_SCHED;
            PG8_STAGE(PG8_SB(0, 1), b2 + hstep, voffB);
            PG8_WAIT_V(6); PG8_BAR; PG8_MMA(1, 1, At, B1); PG8_BAR;
            PG8_LDB(B0, 1, 0); PG8_SCHED; PG8_LDA(At, 1, 0); PG8_STAGE(PG8_SA(0, 1), a2 + hstep, voffA);
            PG8_WAIT_L(8); PG8_BAR; PG8_WAIT_L(0); PG8_MMA(0, 0, At, B0); PG8_BAR; PG8_SCHED;
            PG8_LDB(B1, 1, 1); PG8_STAGE(PG8_SB(1, 0), b3, voffB);
            PG8_BAR; PG8_WAIT_L(0); PG8_MMA(0, 1, At, B1); PG8_BAR;
            PG8_LDA(At, 1, 1); PG8_STAGE(PG8_SA(1, 0), a3, voffA);
            PG8_BAR; PG8_WAIT_L(0); PG8_MMA(1, 0, At, B0); PG8_BAR; PG8_SCHED;
            PG8_STAGE(PG8_SB(1, 1), b3 + hstep, voffB);
            PG8_WAIT_V(6); PG8_BAR; PG8_MMA(1, 1, At, B1); PG8_BAR;
            }
        }
        if constexpr (ALIGN_EPI) { if (wr == 0) PG8_BAR; }
        if constexpr (!Epi::AFTER_DRAIN) { E(acc, cur, wr, wc, fr, fq); S.done(cur); }
        if (!has_next) break;
#pragma unroll
        for (int a = 0; a < 2; ++a)
#pragma unroll
            for (int b = 0; b < 2; ++b)
#pragma unroll
                for (int m = 0; m < 4; ++m)
#pragma unroll
                    for (int n = 0; n < 2; ++n) acc[a][b][m][n] = (f32x4){0.f, 0.f, 0.f, 0.f};
        cur = nxt; cA = nA; cB = nB; ++ui;
        if constexpr (ALIGN_EPI) { if (wr == 1) PG8_BAR; }
    }
    PG8_WAIT_V(0);
    if constexpr (!ALIGN_EPI) { if (wr == 0) PG8_BAR; }
    PG8_BAR;
    if constexpr (Epi::AFTER_DRAIN) { E.fused(acc, cur, wr, wc, fr, fq, lds, wid, lane); S.done(cur); }
#undef PG8_SA
#undef PG8_SB
#undef PG8_STAGE
#undef PG8_LDA
#undef PG8_LDB
#undef PG8_MMA
#undef PG8_WAIT_V
#undef PG8_WAIT_L
#undef PG8_BAR
#undef PG8_SCHED
}
}
#define GAS __attribute__((address_space(1)))
#define LAS __attribute__((address_space(3)))
typedef unsigned short bf16;
typedef unsigned v4u __attribute__((ext_vector_type(4)));
typedef float f32x4 __attribute__((ext_vector_type(4)));
typedef short bf16x8 __attribute__((ext_vector_type(8)));
typedef GAS unsigned gu32;
typedef GAS unsigned long long gu64;
#define RLX_AGENT __ATOMIC_RELAXED, __HIP_MEMORY_SCOPE_AGENT
#define LDS_WAIT() asm volatile("s_waitcnt lgkmcnt(0)" ::: "memory")
#define WG_BAR_LDS() do { asm volatile("s_waitcnt lgkmcnt(0)" ::: "memory"); __builtin_amdgcn_s_barrier(); asm volatile("" ::: "memory"); } while (0)
#define VM_WAIT() asm volatile("s_waitcnt vmcnt(0)" ::: "memory")
__device__ __forceinline__ unsigned long long rt() { return __builtin_amdgcn_s_memrealtime(); }
__device__ __forceinline__ unsigned f2bf(float f) { unsigned u = __builtin_bit_cast(unsigned, f); return (u + 0x7fffu + ((u >> 16) & 1u)) >> 16; }
__device__ __forceinline__ unsigned pk2(float lo, float hi) { return f2bf(lo) | (f2bf(hi) << 16); }

#define XB_TMO      128
#define XB_XCNT(j)  (256  + 64 * (j))
#define XB_XSUB(j)  (1280 + 64 * (j))
#define XB_XGEN(j)  (2304 + 64 * (j))
#define XB_TOP      3328
#define XB_TOPGEN   3392
#define XCD_BAR_WORDS 3456
#define XB_SPIN_CAP (1u << 18)

__device__ __forceinline__ unsigned xb_ld(unsigned* p)              { return __hip_atomic_load(p, __ATOMIC_RELAXED, __HIP_MEMORY_SCOPE_AGENT); }
__device__ __forceinline__ unsigned xb_add(unsigned* p, unsigned v) { return __hip_atomic_fetch_add(p, v, __ATOMIC_RELAXED, __HIP_MEMORY_SCOPE_AGENT); }
__device__ __forceinline__ unsigned xb_xcc_id() { return (unsigned)__builtin_amdgcn_s_getreg((3 << 11) | 20) & 0xFu; }
#define XB_SPIN(cond, bar) do { unsigned _sp = 0; while (cond) { __builtin_amdgcn_s_sleep(1); \
    if ((++_sp & 255u) == 0u) { if (xb_ld(&(bar)[XB_TMO])) break; if (_sp > XB_SPIN_CAP) { atomicAdd(&(bar)[XB_TMO], 1u); break; } } } } while (0)

struct XcdBarrier {
    unsigned* bar; unsigned x;
    volatile LAS unsigned* st;
};

__device__ __forceinline__ XcdBarrier xcd_barrier_post(unsigned* bar, volatile LAS unsigned* st) {
    XcdBarrier b; b.bar = bar; b.x = xb_xcc_id(); b.st = st;
    if (threadIdx.x == 0) (void)xb_add(&bar[XB_XCNT(b.x)], 1u);
    return b;
}
__device__ __forceinline__ void xcd_barrier_complete(unsigned* bar, unsigned x, unsigned& nloc, unsigned& nx) {
    const unsigned G = gridDim.x * gridDim.y * gridDim.z;
    unsigned sum, cnt, mine, sp = 0u;
    for (;;) {
        sum = 0u; cnt = 0u; mine = 0u;
#pragma unroll
        for (unsigned j = 0; j < 16; ++j) { const unsigned c = xb_ld(&bar[XB_XCNT(j)]); sum += c; cnt += (c > 0u) ? 1u : 0u; mine = (j == x) ? c : mine; }
        if (sum == G) break;
        __builtin_amdgcn_s_sleep(1);
        if ((++sp & 255u) == 0u) { if (xb_ld(&bar[XB_TMO])) break; if (sp > XB_SPIN_CAP) { atomicAdd(&bar[XB_TMO], 1u); break; } }
    }
    nloc = mine > 0u ? mine : 1u; nx = cnt > 0u ? cnt : 1u;
}

__device__ __forceinline__ void xcd_barrier(const XcdBarrier& b) {
    asm volatile("s_waitcnt vmcnt(0)" ::: "memory");
    __syncthreads();
    if (threadIdx.x == 0) {
        unsigned* bar = b.bar;
        __builtin_amdgcn_s_waitcnt(0);
        unsigned nloc = b.st[0], nx = b.st[1];
        if (nloc == 0u) { xcd_barrier_complete(bar, b.x, nloc, nx); b.st[0] = nloc; b.st[1] = nx; }
        const unsigned old = xb_add(&bar[XB_XSUB(b.x)], 1u);
        const unsigned gen = old / nloc;
        if (old + 1u == (gen + 1u) * nloc) {
            __builtin_amdgcn_fence(__ATOMIC_RELEASE, "agent");
            asm volatile("s_waitcnt vmcnt(0)" ::: "memory");
            const unsigned og = xb_add(&bar[XB_TOP], 1u);
            const unsigned tg = og / nx;
            if (og + 1u == (tg + 1u) * nx) xb_add(&bar[XB_TOPGEN], 1u);
            else XB_SPIN(xb_ld(&bar[XB_TOPGEN]) == tg, bar);
            __builtin_amdgcn_fence(__ATOMIC_ACQUIRE, "agent");
            xb_add(&bar[XB_XGEN(b.x)], 1u);
            asm volatile("s_waitcnt vmcnt(0)" ::: "memory");
        } else {
            XB_SPIN(xb_ld(&bar[XB_XGEN(b.x)]) == gen, bar);
            __builtin_amdgcn_fence(__ATOMIC_ACQUIRE, "agent");
            asm volatile("s_waitcnt vmcnt(0)" ::: "memory");
        }
    }
    __syncthreads();
}
struct Args { const float* in[25]; float* out; unsigned char* ws; int ph_lo, ph_hi; };
typedef __attribute__((address_space(4))) const unsigned char kbyte;
__device__ __forceinline__ kbyte* kargs() { kbyte* p = (kbyte*)__builtin_amdgcn_kernarg_segment_ptr(); asm volatile("" : "+s"(p)); return p; }
__device__ __forceinline__ const float* ain(int i) { const float* p = (const float*)*(GAS const float* __attribute__((address_space(4))) const*)(kargs() + 8 * i); ASSUME_GLOBAL(p); return p; }
__device__ __forceinline__ float* aout() { return (float*)*(GAS float* __attribute__((address_space(4))) const*)(kargs() + 200); }
__device__ __forceinline__ unsigned char* aws() { return (unsigned char*)*(GAS unsigned char* __attribute__((address_space(4))) const*)(kargs() + 208); }
__device__ __forceinline__ int aint(int off) { return *(const int __attribute__((address_space(4)))*)(kargs() + off); }
static_assert(sizeof(Args) == 224, "Args layout");
struct Frame {
    LAS unsigned char* lds;
    unsigned char* ws;
    int wave, vcu, G;
};
__device__ __forceinline__ pg8::ssq_t ssq_arr(const Frame& F, int k) { return pg8::ssqp(F.ws, k); }
__device__ __forceinline__ bf16* wsb(const Frame& F, size_t off) { return (bf16*)(F.ws + off); }
__device__ __forceinline__ float bf2f(bf16 v) { return __uint_as_float((unsigned)v << 16); }
__device__ __forceinline__ int opaque(int v) { asm volatile("" : "+v"(v)); return v; }
__device__ __forceinline__ int opaque_s(int v) { asm volatile("" : "+s"(v)); return v; }
__device__ __forceinline__ float wave_sum(float v) {
#pragma unroll
    for (int o = 1; o < 64; o <<= 1) v += __shfl_xor(v, o);
    return v;
}
__device__ __forceinline__ float wave_max(float v) {
#pragma unroll
    for (int o = 1; o < 64; o <<= 1) v = fmaxf(v, __shfl_xor(v, o));
    return v;
}

__device__ __forceinline__ int win_srccol(int n) {
    const int t = n >> 8, c = n & 255;
    switch (t) {
        case 0: return Z_MQ + c; case 1: return Z_MK + c; case 2: case 3: return Z_MV + (n - 512); case 4: case 5: return Z_MO + (n - 1024); case 6: return Z_CQ + c;
        case 7: if (c < 128) return Z_CKV + c; if (c < 192) return Z_KIDX + (c - 128); if (c < 200) return Z_WIDX + (c - 192); if (c < 204) return Z_MI + (c - 200); if (c < 208) return Z_MF + (c - 204); return -1;
        case 8: case 9: case 10: case 11: {
            const int base = (t < 10) ? Z_RQ : Z_RK, hh = 2 * (t & 1) + (c >> 7), p = c & 127, j8 = p >> 3, e = p & 7;
            return base + hh * 128 + ((e < 4) ? (4 * j8 + e) : (64 + 4 * j8 + (e - 4))); }
        case 12: case 13: return Z_RV + (n - 3072);
        default: return Z_RG + (n - 3584);
    }
}
__device__ __forceinline__ void tr_item(const float* p, int ld, const float* kscale, int K, bf16* WT, int k0, int n0, LAS float* scr, int lane) {
#pragma unroll
    for (int i = 0; i < 8; ++i) { const int kk = (lane >> 3) + 8 * i; f32x4 v = (f32x4){0.f, 0.f, 0.f, 0.f};
        if (p) { v = *(const GAS f32x4*)(p + (size_t)(k0 + kk) * ld); if (kscale) v = v * kscale[k0 + kk]; }
        LAS float* d = scr + kk * 33 + 4 * (lane & 7); d[0] = v.x; d[1] = v.y; d[2] = v.z; d[3] = v.w; }
    LDS_WAIT(); asm volatile("" ::: "memory");
    const int c = lane & 7;
#pragma unroll
    for (int j = 0; j < 4; ++j) { const int n = (lane >> 3) + 8 * j; const LAS float* s = scr + (8 * c) * 33 + n;
        v4u o; o.x = pk2(s[0 * 33], s[1 * 33]); o.y = pk2(s[2 * 33], s[3 * 33]); o.z = pk2(s[4 * 33], s[5 * 33]); o.w = pk2(s[6 * 33], s[7 * 33]);
        *(GAS v4u*)(WT + (size_t)(n0 + n) * K + k0 + 8 * c) = o; }
    LDS_WAIT(); asm volatile("" ::: "memory");
}
__device__ __forceinline__ void p0_prologue(Frame& F) {
    LAS float* scr = (LAS float*)(F.lds + RING_OFF + F.wave * 16384);
    const int gw = F.vcu * NWAVES + F.wave, NGW = F.G * NWAVES, lane = (opaque((int)threadIdx.x) & 63);
    constexpr int I_IN = 16 * 128, I_G = 16 * 96, I_Q2 = 4 * 16, I_PM = 8 * 32, I_PR = 8 * 32, I_OUT = 16 * 32, I_GU = 16 * 176, I_DN = 44 * 32;
    constexpr int I_LAYER = I_IN + I_G + I_Q2 + I_PM + I_PR + I_OUT + I_GU + I_DN;
    for (int it = gw; it < 2 * I_LAYER; it += NGW) {
        const int l = it / I_LAYER; int r = it % I_LAYER;
        unsigned char* wl = F.ws + WS_W + (size_t)l * W_LAYER;
        const float* w_in = ain(4) + (size_t)l * D * DIN;
        const int nl = 4 * (lane & 7);
        if (r < I_IN) { const int kb = r / 128, nb = r % 128, n = 32 * nb + nl, sc = win_srccol(n);
            tr_item(sc >= 0 ? w_in + sc : nullptr, DIN, ain(3) + l * D, 1024, (bf16*)(wl + W_IN), 64 * kb, 32 * nb, scr, lane); continue; } r -= I_IN;
        if (r < I_G) { const int kb = r / 96, nb = r % 96, n = 32 * nb + nl;
            tr_item(w_in + Z_GM + n, DIN, ain(3) + l * D, 1024, (bf16*)(wl + W_G), 64 * kb, 32 * nb, scr, lane); continue; } r -= I_G;
        if (r < I_Q2) { const int kb = r / 16, nb = r % 16, n = 32 * nb + nl;
            tr_item(ain(11) + (size_t)l * 256 * 512 + n, 512, ain(9) + l * 256, 256, (bf16*)(wl + W_Q2) + (size_t)1024 * 256, 64 * kb, 32 * nb, scr, lane); continue; } r -= I_Q2;
        if (r < I_PM) { const int kb = r / 32, nb = r % 32, n = 32 * nb + nl;
            tr_item(ain(17) + (size_t)l * 512 * 1024 + n, 1024, nullptr, 512, (bf16*)(wl + W_PM), 64 * kb, 32 * nb, scr, lane); continue; } r -= I_PM;
        if (r < I_PR) { const int kb = r / 32, nb = r % 32, n = 32 * nb + nl;
            tr_item(ain(19) + (size_t)l * 512 * 1024 + n, 1024, nullptr, 512, (bf16*)(wl + W_PR), 64 * kb, 32 * nb, scr, lane); continue; } r -= I_PR;
        if (r < I_OUT) { const int kb = r / 32, nb = r % 32, n = 32 * nb + nl;
            tr_item(ain(20) + (size_t)l * 1024 * 1024 + n, 1024, nullptr, 1024, (bf16*)(wl + W_OUT), 64 * kb, 32 * nb, scr, lane); continue; } r -= I_OUT;
        if (r < I_GU) { const int kb = r / 176, nb = r % 176, n = 32 * nb + nl, tile = n >> 8, rr = n & 255;
            const float* src = (rr < 128) ? ain(22) + (size_t)l * D * DFF + 128 * tile + rr : ain(23) + (size_t)l * D * DFF + 128 * tile + (rr - 128);
            tr_item(src, DFF, ain(21) + l * D, 1024, (bf16*)(wl + W_GU), 64 * kb, 32 * nb, scr, lane); continue; } r -= I_GU;
        { const int kb = r / 32, nb = r % 32, n = 32 * nb + nl;
            tr_item(ain(24) + (size_t)l * DFF * D + n, 1024, nullptr, 2816, (bf16*)(wl + W_DN), 64 * kb, 32 * nb, scr, lane); }
    }
    for (int it = gw; it < 2 * 512; it += NGW) {
        const int l = it >> 9, r = it & 511, k0 = (r >> 4) * 8, n = (r & 15) * 64 + lane, h = n >> 7, c = n & 127;
        const float* av = ain(10) + (size_t)l * 256 * 512 + (size_t)k0 * 512 + h * 64;
        const float* bv = ain(14) + (size_t)l * 8 * 64 * 128 + (size_t)h * 64 * 128 + c;
        float acc[8];
#pragma unroll
        for (int e = 0; e < 8; ++e) acc[e] = 0.f;
#pragma unroll 16
        for (int d = 0; d < 64; ++d) { const float x = bv[(size_t)d * 128];
#pragma unroll
            for (int e = 0; e < 8; ++e) acc[e] = fmaf(av[e * 512 + d], x, acc[e]); }
        const float* gq = ain(9) + l * 256 + k0;
        v4u o; o.x = pk2(acc[0] * 0.125f * gq[0], acc[1] * 0.125f * gq[1]); o.y = pk2(acc[2] * 0.125f * gq[2], acc[3] * 0.125f * gq[3]);
        o.z = pk2(acc[4] * 0.125f * gq[4], acc[5] * 0.125f * gq[5]); o.w = pk2(acc[6] * 0.125f * gq[6], acc[7] * 0.125f * gq[7]);
        *(GAS v4u*)((bf16*)(F.ws + WS_W + (size_t)l * W_LAYER + W_Q2) + (size_t)n * 256 + k0) = o;
    }
    for (int it = gw; it < 2 * 2048; it += NGW) {
        const int l = it >> 11, r = it & 2047, kk0 = (r >> 4) * 8, n = (r & 15) * 64 + lane, h = kk0 >> 7;
        const float* av = ain(15) + (size_t)l * 8 * 128 * 64 + (size_t)kk0 * 64;
        const float* bv = ain(18) + (size_t)l * 512 * 1024 + (size_t)(h * 64) * 1024 + n;
        float acc[8];
#pragma unroll
        for (int e = 0; e < 8; ++e) acc[e] = 0.f;
#pragma unroll 16
        for (int d = 0; d < 64; ++d) { const float x = bv[(size_t)d * 1024];
#pragma unroll
            for (int e = 0; e < 8; ++e) acc[e] = fmaf(av[e * 64 + d], x, acc[e]); }
        v4u o; o.x = pk2(acc[0], acc[1]); o.y = pk2(acc[2], acc[3]); o.z = pk2(acc[4], acc[5]); o.w = pk2(acc[6], acc[7]);
        *(GAS v4u*)((bf16*)(F.ws + WS_W + (size_t)l * W_LAYER + W_AV) + (size_t)n * 1024 + kk0) = o;
    }
    const int gt = F.vcu * NWAVES * 64 + F.wave * 64 + lane, NGT = F.G * NWAVES * 64;
    float* rot = (float*)(F.ws + WS_ROT);
    for (int e = gt; e < 2048 * 64; e += NGT) {
        const int t = e >> 6, i = e & 63;
        const float freq = (float)pow(10000.0, -(double)((float)i / 63.0f)), ang = (float)t * freq;
        rot[(size_t)t * 128 + i] = cosf(ang); rot[(size_t)t * 128 + 64 + i] = sinf(ang);
    }
    pg8::ssq_t ssq = ssq_arr(F, 0); bf16* XB = wsb(F, WS_XB);
#pragma unroll 4
    for (int m = gw; m < M; m += NGW) {
        const GAS f32x4* xr = (const GAS f32x4*)(ain(0) + (size_t)m * D) + lane;
        GAS unsigned long long* o8 = (GAS unsigned long long*)(XB + (size_t)m * D) + lane; float s = 0.f;
#pragma unroll
        for (int j = 0; j < 4; ++j) { const f32x4 v = xr[64 * j]; s += (v.x * v.x + v.y * v.y) + (v.z * v.z + v.w * v.w);
            o8[64 * j] = (unsigned long long)pk2(v.x, v.y) | ((unsigned long long)pk2(v.z, v.w) << 32); }
        s = wave_sum(s); if (lane == 0) ssq[m] = __float2ll_rn(s * 1048576.f);
    }
}

__device__ __forceinline__ void p2_norms(Frame& F, int l) {
    const int gw = F.vcu * NWAVES + F.wave, NGW = F.G * NWAVES, lane = (opaque((int)threadIdx.x) & 63);
    const pg8::ssq_t ssq_ckv = ssq_arr(F, l * 6 + 3), sum_k = ssq_arr(F, l * 6 + 4), ssq_k = ssq_arr(F, l * 6 + 5);
    const bf16* CKV = wsb(F, WS_CKV); const bf16* KIDX = wsb(F, WS_KIDX); bf16* CKVN = wsb(F, WS_CKVN); bf16* KIDXN = wsb(F, WS_KIDXN);
    const int sub = lane & 15, rsel = lane >> 4;
    f32x4 gkv = *(const GAS f32x4*)(ain(12) + l * 64 + 4 * sub), gca = *(const GAS f32x4*)(ain(13) + l * 128 + 8 * sub), gcb = *(const GAS f32x4*)(ain(13) + l * 128 + 8 * sub + 4);
    for (int m4 = gw; m4 < M / 4; m4 += NGW) {
        const int m = 4 * m4 + rsel;
        const float mean = pg8::sget(sum_k, m) * (1.f / 64.f), var = pg8::sget(ssq_k, m) * (1.f / 64.f) - mean * mean, rk = rsqrtf(fmaxf(var, 0.f) + EPSN);
        const float rc = rsqrtf(pg8::sget(ssq_ckv, m) * (1.f / 128.f) + EPSN);
        const unsigned long long kq = *(const GAS unsigned long long*)(KIDX + (size_t)m * 64 + 4 * sub);
        const v4u cq = *(const GAS v4u*)(CKV + (size_t)m * 128 + 8 * sub);
        const unsigned k0 = (unsigned)kq, k1 = (unsigned)(kq >> 32);
        const unsigned o0 = pk2((__uint_as_float(k0 << 16) - mean) * rk * gkv.x, (__uint_as_float(k0 & 0xffff0000u) - mean) * rk * gkv.y);
        const unsigned o1 = pk2((__uint_as_float(k1 << 16) - mean) * rk * gkv.z, (__uint_as_float(k1 & 0xffff0000u) - mean) * rk * gkv.w);
        *(GAS unsigned long long*)(KIDXN + (size_t)m * 64 + 4 * sub) = (unsigned long long)o0 | ((unsigned long long)o1 << 32);
        v4u co;
        co.x = pk2(__uint_as_float(cq.x << 16) * rc * gca.x, __uint_as_float(cq.x & 0xffff0000u) * rc * gca.y);
        co.y = pk2(__uint_as_float(cq.y << 16) * rc * gca.z, __uint_as_float(cq.y & 0xffff0000u) * rc * gca.w);
        co.z = pk2(__uint_as_float(cq.z << 16) * rc * gcb.x, __uint_as_float(cq.z & 0xffff0000u) * rc * gcb.y);
        co.w = pk2(__uint_as_float(cq.w << 16) * rc * gcb.z, __uint_as_float(cq.w & 0xffff0000u) * rc * gcb.w);
        *(GAS v4u*)(CKVN + (size_t)m * 128 + 8 * sub) = co;
    }
}

typedef short s16x4 __attribute__((ext_vector_type(4)));
__device__ __forceinline__ unsigned offb(unsigned row, unsigned ch) { return 256u * row + 16u * (ch ^ (((row & 3u) << 2) | ((row >> 2) & 3u))); }
__device__ __forceinline__ bf16x8 frag_row(LAS unsigned char* img, int rowbase, int s, int lane) { return *(LAS bf16x8*)(img + offb(rowbase + (lane & 15), 4 * s + (lane >> 4))); }
template <bool PERM> __device__ __forceinline__ bf16x8 frag_tr(LAS unsigned char* img, int kbase, int c, int lane) {
    const unsigned g = lane >> 4, qq = (lane & 15) >> 2, pp = lane & 3;
    const unsigned r0 = kbase + (PERM ? 4 * g : 8 * g) + qq, r1 = r0 + (PERM ? 16 : 4), chn = 2 * c + (pp >> 1), bo = 8 * (pp & 1);
    const s16x4 lo = __builtin_amdgcn_ds_read_tr16_b64_v4i16((LAS s16x4*)(img + offb(r0, chn) + bo)), hi = __builtin_amdgcn_ds_read_tr16_b64_v4i16((LAS s16x4*)(img + offb(r1, chn) + bo));
    return (bf16x8){lo[0], lo[1], lo[2], lo[3], hi[0], hi[1], hi[2], hi[3]};
}
__device__ __forceinline__ unsigned offb2(unsigned row, unsigned ch) { return 256u * row + 16u * (ch ^ (((row & 3u) << 1) | ((row >> 3) & 1u) | ((((row >> 2) ^ (row >> 3)) & 1u) << 3))); }
__device__ __forceinline__ bf16x8 frag_row2(LAS unsigned char* img, int rowbase, int s, int lane) { return *(LAS bf16x8*)(img + offb2(rowbase + (lane & 15), 4 * s + (lane >> 4))); }
__device__ __forceinline__ bf16x8 frag_tr2(LAS unsigned char* img, int kbase, int c, int lane) {
    const unsigned g = lane >> 4, qq = (lane & 15) >> 2, pp = lane & 3;
    const unsigned r0 = kbase + 4 * g + qq, r1 = r0 + 16, chn = 2 * c + (pp >> 1), bo = 8 * (pp & 1);
    const s16x4 lo = __builtin_amdgcn_ds_read_tr16_b64_v4i16((LAS s16x4*)(img + offb2(r0, chn) + bo)), hi = __builtin_amdgcn_ds_read_tr16_b64_v4i16((LAS s16x4*)(img + offb2(r1, chn) + bo));
    return (bf16x8){lo[0], lo[1], lo[2], lo[3], hi[0], hi[1], hi[2], hi[3]};
}
typedef float f32x2_t __attribute__((ext_vector_type(2)));
typedef __bf16 bf16x2_t __attribute__((ext_vector_type(2)));
__device__ __forceinline__ unsigned pkbf(float a, float b) { const f32x2_t v = {a, b}; return __builtin_bit_cast(unsigned, __builtin_convertvector(v, bf16x2_t)); }
__device__ __forceinline__ bf16x8 pack_acc2(const f32x4& a, const f32x4& b) { v4u w; w.x = pkbf(a[0], a[1]); w.y = pkbf(a[2], a[3]); w.z = pkbf(b[0], b[1]); w.w = pkbf(b[2], b[3]); return __builtin_bit_cast(bf16x8, w); }
__device__ __forceinline__ v4u scale8(v4u x, float f) { v4u r;
    r.x = pkbf(__uint_as_float(x.x << 16) * f, __uint_as_float(x.x & 0xffff0000u) * f); r.y = pkbf(__uint_as_float(x.y << 16) * f, __uint_as_float(x.y & 0xffff0000u) * f);
    r.z = pkbf(__uint_as_float(x.z << 16) * f, __uint_as_float(x.z & 0xffff0000u) * f); r.w = pkbf(__uint_as_float(x.w << 16) * f, __uint_as_float(x.w & 0xffff0000u) * f); return r; }
#define MFMA16(a, b, c) __builtin_amdgcn_mfma_f32_16x16x32_bf16((a), (b), (c), 0, 0, 0)
#define SETTLE(x) do { __builtin_amdgcn_sched_barrier(0); asm volatile("s_nop 15\n\ts_nop 15"); __builtin_amdgcn_sched_barrier(0); } while (0)

__device__ __forceinline__ float row16_sum(float v) {
    v += __int_as_float(__builtin_amdgcn_update_dpp(0, __float_as_int(v), 0x121, 0xf, 0xf, false));
    v += __int_as_float(__builtin_amdgcn_update_dpp(0, __float_as_int(v), 0x122, 0xf, 0xf, false));
    v += __int_as_float(__builtin_amdgcn_update_dpp(0, __float_as_int(v), 0x124, 0xf, 0xf, false));
    v += __int_as_float(__builtin_amdgcn_update_dpp(0, __float_as_int(v), 0x128, 0xf, 0xf, false));
    return v;
}
__device__ __forceinline__ void retention_unit(Frame& F, int lyr, int b_, int h_) {
    const int b = opaque_s(b_), h = opaque_s(h_);
    const int lane = opaque((int)threadIdx.x) & 63, w = F.wave, tid = w * 64 + lane;
    LAS unsigned char* TQ = F.lds; LAS unsigned char* TK = TQ + 32768; LAS unsigned char* TV = TK + 32768; LAS unsigned char* TS = TV + 32768;
    const int g = lane >> 4, m16 = lane & 15;
    const float lg = log2f(1.f - exp2f(-5.f - (float)h));
    for (int i = tid; i < 2048; i += 512) *(LAS v4u*)(TS + 16 * i) = (v4u){0u, 0u, 0u, 0u};
    f32x4 Sacc[8];
#pragma unroll
    for (int ct = 0; ct < 8; ++ct) Sacc[ct] = (f32x4){0.f, 0.f, 0.f, 0.f};
    const bf16* RQ = wsb(F, WS_RQ); const bf16* RK = wsb(F, WS_RK); bf16* RV = wsb(F, WS_RV); const bf16* RG = wsb(F, WS_RG);
    const float* gn = ain(16) + lyr * 512 + h * 128;
    const int srow = tid >> 4, sch = tid & 15;
    const size_t gbase = ((size_t)b * S) * 512 + h * 128 + sch * 8;
    float rowdec[4];
#pragma unroll
    for (int r = 0; r < 4; ++r) rowdec[r] = exp2f((float)(16 * w + 4 * g + r + 1) * lg);
    const float colf = exp2f((float)(16 * w + m16 - 127) * lg), sdec = exp2f(128.f * lg);
    const int npair = (w >> 1) + 1;
    for (int c = 0; c < 16; ++c) {
#pragma unroll
        for (int i = 0; i < 4; ++i) { const int row = srow + 32 * i; const unsigned o = offb(row, sch); const size_t go = gbase + (size_t)(c * 128 + row) * 512;
            const v4u vq = *(const GAS v4u*)(RQ + go), vk = *(const GAS v4u*)(RK + go), vv = *(const GAS v4u*)(RV + go);
            *(LAS v4u*)(TQ + o) = vq; *(LAS v4u*)(TK + o) = scale8(vk, exp2f((float)(127 - row) * lg)); *(LAS v4u*)(TV + o) = vv; }
        WG_BAR_LDS();
        bf16x8 qf[4];
#pragma unroll
        for (int s = 0; s < 4; ++s) qf[s] = frag_row(TQ, 16 * w, s, lane);
        f32x4 O[8];
#pragma unroll
        for (int ct = 0; ct < 8; ++ct) { f32x4 a = (f32x4){0.f, 0.f, 0.f, 0.f};
#pragma unroll
            for (int s = 0; s < 4; ++s) a = MFMA16(qf[s], frag_tr<false>(TS, 32 * s, ct, lane), a);
            SETTLE(a);
#pragma unroll
            for (int r = 0; r < 4; ++r) a[r] *= rowdec[r];
            O[ct] = a; }
        for (int jp = 0; jp < npair; ++jp) {
            f32x4 c1[2];
#pragma unroll
            for (int hb = 0; hb < 2; ++hb) { f32x4 a = (f32x4){0.f, 0.f, 0.f, 0.f}; const int rb = 2 * jp + hb;
#pragma unroll
                for (int s = 0; s < 4; ++s) a = MFMA16(frag_row(TK, 16 * rb, s, lane), qf[s], a);
                SETTLE(a);
#pragma unroll
                for (int r = 0; r < 4; ++r) a[r] = (16 * rb + 4 * g + r <= 16 * w + m16) ? a[r] * colf : 0.f;
                c1[hb] = a; }
            const bf16x8 pf = pack_acc2(c1[0], c1[1]);
#pragma unroll
            for (int ct = 0; ct < 8; ++ct) O[ct] = MFMA16(pf, frag_tr<true>(TV, 32 * jp, ct, lane), O[ct]);
        }
#pragma unroll
        for (int ct = 0; ct < 8; ++ct) Sacc[ct] = Sacc[ct] * sdec;
#pragma unroll
        for (int s = 0; s < 4; ++s) { const bf16x8 kt = frag_tr<false>(TK, 32 * s, w, lane);
#pragma unroll
            for (int ct = 0; ct < 8; ++ct) Sacc[ct] = MFMA16(kt, frag_tr<false>(TV, 32 * s, ct, lane), Sacc[ct]); }
        float mean[4], rstd[4];
#pragma unroll
        for (int r = 0; r < 4; ++r) { float s1 = 0.f;
#pragma unroll
            for (int ct = 0; ct < 8; ++ct) s1 += O[ct][r];
            s1 = row16_sum(s1);
            mean[r] = s1 * (1.f / 128.f); float s2 = 0.f;
#pragma unroll
            for (int ct = 0; ct < 8; ++ct) { const float d = O[ct][r] - mean[r]; s2 += d * d; }
            s2 = row16_sum(s2);
            rstd[r] = rsqrtf(s2 * (1.f / 128.f) + EPSN); }
        { const int lq_ = opaque(lane), gq = lq_ >> 4, mq = lq_ & 15;
          LAS unsigned char* st = TQ + 4096 * w;
#pragma unroll
          for (int ct = 0; ct < 8; ++ct) { const float gv = gn[16 * ct + mq];
#pragma unroll
            for (int r = 0; r < 4; ++r) *(LAS bf16*)(st + (4 * gq + r) * 256 + (16 * ct + mq) * 2) = (bf16)f2bf((O[ct][r] - mean[r]) * rstd[r] * gv); }
          LDS_WAIT(); asm volatile("" ::: "memory");
#pragma unroll
          for (int i = 0; i < 4; ++i) { const int n = lq_ + 64 * i, row = n >> 4, ch = n & 15;
            const v4u xv = *(LAS v4u*)(st + row * 256 + ch * 16);
            const size_t o = ((size_t)b * S + c * 128 + 16 * w + row) * 512 + h * 128 + ch * 8;
            const v4u gt = *(const GAS v4u*)(RG + o); v4u ov;
            { const float g0 = __uint_as_float(gt.x << 16), g1 = __uint_as_float(gt.x & 0xffff0000u); ov.x = pkbf(__uint_as_float(xv.x << 16) * g0 / (1.f + __expf(-g0)), __uint_as_float(xv.x & 0xffff0000u) * g1 / (1.f + __expf(-g1))); }
            { const float g0 = __uint_as_float(gt.y << 16), g1 = __uint_as_float(gt.y & 0xffff0000u); ov.y = pkbf(__uint_as_float(xv.y << 16) * g0 / (1.f + __expf(-g0)), __uint_as_float(xv.y & 0xffff0000u) * g1 / (1.f + __expf(-g1))); }
            { const float g0 = __uint_as_float(gt.z << 16), g1 = __uint_as_float(gt.z & 0xffff0000u); ov.z = pkbf(__uint_as_float(xv.z << 16) * g0 / (1.f + __expf(-g0)), __uint_as_float(xv.z & 0xffff0000u) * g1 / (1.f + __expf(-g1))); }
            { const float g0 = __uint_as_float(gt.w << 16), g1 = __uint_as_float(gt.w & 0xffff0000u); ov.w = pkbf(__uint_as_float(xv.w << 16) * g0 / (1.f + __expf(-g0)), __uint_as_float(xv.w & 0xffff0000u) * g1 / (1.f + __expf(-g1))); }
            *(GAS v4u*)(RV + o) = ov; }
        }
        WG_BAR_LDS();
        const int lo_ = opaque(lane), go = lo_ >> 4, mo = lo_ & 15;
#pragma unroll
        for (int ct = 0; ct < 8; ++ct)
#pragma unroll
            for (int r = 0; r < 4; ++r) { const unsigned row = 16 * w + 4 * go + r, col = 16 * ct + mo;
                *(LAS bf16*)(TS + offb(row, col >> 3) + 2 * (col & 7)) = (bf16)f2bf(Sacc[ct][r]); }
    }
    WG_BAR_LDS();
}
__device__ __forceinline__ float log_sigmoid(float x) { return fminf(x, 0.f) - log1pf(__expf(-fabsf(x))); }
__device__ __forceinline__ void mlstm_unit(Frame& F, int lyr, int b_, int h_) {
    const int b = opaque_s(b_), h = opaque_s(h_);
    const int lane = opaque((int)threadIdx.x) & 63, w = F.wave, tid = w * 64 + lane;
    LAS unsigned char* TQK = F.lds; LAS unsigned char* TV = TQK + 32768; LAS unsigned char* TS = TV + 32768; LAS unsigned char* TN = TS + 16384;
    LAS float* GB = (LAS float*)(TN + 16384);
    LAS float* G_bc = GB, *G_u = GB + 128, *G_pm = GB + 256, *G_s0 = GB + 384, *G_sc = GB + 640;
    const int g = lane >> 4, m16 = lane & 15;
    for (int i = tid; i < 2048; i += 512) *(LAS v4u*)(TS + 16 * i) = (v4u){0u, 0u, 0u, 0u};
    f32x4 Cacc[4], nacc = (f32x4){0.f, 0.f, 0.f, 0.f};
#pragma unroll
    for (int j = 0; j < 4; ++j) Cacc[j] = (f32x4){0.f, 0.f, 0.f, 0.f};
    const bf16* MQK = wsb(F, WS_MQK); bf16* MV = wsb(F, WS_MV); const bf16* MO = wsb(F, WS_MO); const float* MIF = (const float*)(F.ws + WS_MIF);
    const float* gn = ain(8) + lyr * 512 + h * 128;
    const int srow = tid >> 4, sch = tid & 15;
    const int qkcol = (sch < 8) ? (h * 64 + 8 * sch) : (256 + h * 64 + 8 * (sch - 8));
    float cw[4][8];
    { const float* cv = ain(5) + (size_t)lyr * 4 * 512 + qkcol;
#pragma unroll
      for (int j = 0; j < 4; ++j)
#pragma unroll
        for (int e = 0; e < 8; ++e) cw[j][e] = cv[j * 512 + e]; }
    const float qsc = (sch < 8) ? 0.125f : 1.f;
    const bf16x8 ones = (bf16x8){0x3f80, 0x3f80, 0x3f80, 0x3f80, 0x3f80, 0x3f80, 0x3f80, 0x3f80};
    float m_st = 0.f;
    const int npair = (w >> 1) + 1, kt = w & 3, vt0 = 4 * (w >> 2);
    for (int c = 0; c < 16; ++c) {
#pragma unroll 1
        for (int i = 0; i < 4; ++i) { const int row = srow + 32 * i, t = c * 128 + row; const size_t rbase = ((size_t)b * S + t) * 512;
            float a[8];
#pragma unroll
            for (int e = 0; e < 8; ++e) a[e] = 0.f;
#pragma unroll
            for (int j = 0; j < 4; ++j) { const int tt = t - 3 + j;
                if (tt >= 0) { const v4u x = *(const GAS v4u*)(MQK + (rbase - (size_t)(3 - j) * 512) + qkcol);
                    a[0] = fmaf(cw[j][0], __uint_as_float(x.x << 16), a[0]); a[1] = fmaf(cw[j][1], __uint_as_float(x.x & 0xffff0000u), a[1]);
                    a[2] = fmaf(cw[j][2], __uint_as_float(x.y << 16), a[2]); a[3] = fmaf(cw[j][3], __uint_as_float(x.y & 0xffff0000u), a[3]);
                    a[4] = fmaf(cw[j][4], __uint_as_float(x.z << 16), a[4]); a[5] = fmaf(cw[j][5], __uint_as_float(x.z & 0xffff0000u), a[5]);
                    a[6] = fmaf(cw[j][6], __uint_as_float(x.w << 16), a[6]); a[7] = fmaf(cw[j][7], __uint_as_float(x.w & 0xffff0000u), a[7]); } }
#pragma unroll
            for (int e = 0; e < 8; ++e) a[e] = a[e] / (1.f + __expf(-a[e])) * qsc;
            v4u o; o.x = pkbf(a[0], a[1]); o.y = pkbf(a[2], a[3]); o.z = pkbf(a[4], a[5]); o.w = pkbf(a[6], a[7]);
            *(LAS v4u*)(TQK + offb(row, sch)) = o;
            *(LAS v4u*)(TV + offb(row, sch)) = *(const GAS v4u*)(MV + rbase + h * 128 + sch * 8); }
        if (w == 0) {
            const size_t r0 = (size_t)b * S + c * 128;
            float x0 = log_sigmoid(MIF[(r0 + lane) * 8 + 4 + h]), x1 = log_sigmoid(MIF[(r0 + lane + 64) * 8 + 4 + h]);
            const float li0 = MIF[(r0 + lane) * 8 + h], li1 = MIF[(r0 + lane + 64) * 8 + h];
#pragma unroll 1
            for (int d = 1; d < 128; d <<= 1) { G_s0[lane] = x0; G_s0[lane + 64] = x1; LDS_WAIT(); asm volatile("" ::: "memory");
                const float y0 = (lane >= d) ? G_s0[lane - d] : 0.f, y1 = G_s0[lane + 64 - d]; LDS_WAIT(); asm volatile("" ::: "memory"); x0 += y0; x1 += y1; }
            G_bc[lane] = x0; G_bc[lane + 64] = x1;
            float u0 = li0 - x0, u1 = li1 - x1; G_u[lane] = u0; G_u[lane + 64] = u1;
            const float blast = __int_as_float(__builtin_amdgcn_readlane(__float_as_int(x1), 63));
#pragma unroll 1
            for (int d = 1; d < 128; d <<= 1) { G_s0[lane] = u0; G_s0[lane + 64] = u1; LDS_WAIT(); asm volatile("" ::: "memory");
                const float y0 = (lane >= d) ? G_s0[lane - d] : -INFINITY, y1 = G_s0[lane + 64 - d]; LDS_WAIT(); asm volatile("" ::: "memory"); u0 = fmaxf(u0, y0); u1 = fmaxf(u1, y1); }
            u0 = fmaxf(u0, m_st); u1 = fmaxf(u1, m_st);
            G_pm[lane] = u0; G_pm[lane + 64] = u1;
            const float pml = __int_as_float(__builtin_amdgcn_readlane(__float_as_int(u1), 63));
            if (lane == 0) { G_sc[0] = m_st; G_sc[1] = pml; }
            m_st = blast + pml;
        }
        WG_BAR_LDS();
        const int lc = opaque(lane), gq = lc >> 4, mq = lc & 15;
        const float mst_c = G_sc[0], pm_last = G_sc[1];
        bf16x8 qf[2];
#pragma unroll
        for (int s = 0; s < 2; ++s) qf[s] = frag_row(TQK, 16 * w, s, lc);
        f32x4 O[9];
        const f32x4 pmr = *(LAS f32x4*)(G_pm + 16 * w + 4 * gq), bcr = *(LAS f32x4*)(G_bc + 16 * w + 4 * gq);
        float wint[4];
#pragma unroll
        for (int r = 0; r < 4; ++r) wint[r] = __expf(mst_c - pmr[r]);
#pragma unroll
        for (int ct = 0; ct < 9; ++ct) { f32x4 a = (f32x4){0.f, 0.f, 0.f, 0.f};
#pragma unroll
            for (int s = 0; s < 2; ++s) a = MFMA16(qf[s], (ct < 8) ? frag_tr<false>(TS, 32 * s, ct, lc) : frag_tr<false>(TN, 32 * s, 0, lc), a);
#pragma unroll
            for (int r = 0; r < 4; ++r) a[r] *= wint[r];
            O[ct] = a; }
        const float pml_ = G_pm[16 * w + mq];
        for (int jp = 0; jp < npair; ++jp) {
            f32x4 c1[2];
#pragma unroll
            for (int hb = 0; hb < 2; ++hb) { f32x4 a = (f32x4){0.f, 0.f, 0.f, 0.f}; const int rb = 2 * jp + hb;
#pragma unroll
                for (int s = 0; s < 2; ++s) a = MFMA16(frag_row(TQK, 16 * rb, 2 + s, lc), qf[s], a);
                const f32x4 ur = *(LAS f32x4*)(G_u + 16 * rb + 4 * gq);
#pragma unroll
                for (int r = 0; r < 4; ++r) a[r] = (16 * rb + 4 * gq + r <= 16 * w + mq) ? a[r] * __expf(ur[r] - pml_) : 0.f;
                c1[hb] = a; }
            const bf16x8 pf = pack_acc2(c1[0], c1[1]);
#pragma unroll
            for (int ct = 0; ct < 8; ++ct) O[ct] = MFMA16(pf, frag_tr<true>(TV, 32 * jp, ct, lc), O[ct]);
            O[8] = MFMA16(pf, ones, O[8]);
        }
        { const float decay = __expf(mst_c - pm_last);
#pragma unroll
          for (int j = 0; j < 4; ++j) Cacc[j] = Cacc[j] * decay;
          nacc = nacc * decay;
#pragma unroll
          for (int s = 0; s < 4; ++s) { const bf16x8 kraw = frag_tr<false>(TQK, 32 * s, 4 + kt, lc);
            const f32x4 ua = *(LAS f32x4*)(G_u + 32 * s + 8 * gq), ub = *(LAS f32x4*)(G_u + 32 * s + 8 * gq + 4);
            const v4u kr = __builtin_bit_cast(v4u, kraw); v4u ks;
            ks.x = pkbf(__uint_as_float(kr.x << 16) * __expf(ua[0] - pm_last), __uint_as_float(kr.x & 0xffff0000u) * __expf(ua[1] - pm_last));
            ks.y = pkbf(__uint_as_float(kr.y << 16) * __expf(ua[2] - pm_last), __uint_as_float(kr.y & 0xffff0000u) * __expf(ua[3] - pm_last));
            ks.z = pkbf(__uint_as_float(kr.z << 16) * __expf(ub[0] - pm_last), __uint_as_float(kr.z & 0xffff0000u) * __expf(ub[1] - pm_last));
            ks.w = pkbf(__uint_as_float(kr.w << 16) * __expf(ub[2] - pm_last), __uint_as_float(kr.w & 0xffff0000u) * __expf(ub[3] - pm_last));
            const bf16x8 kw = __builtin_bit_cast(bf16x8, ks);
#pragma unroll
            for (int j = 0; j < 4; ++j) Cacc[j] = MFMA16(kw, frag_tr<false>(TV, 32 * s, vt0 + j, lc), Cacc[j]);
            nacc = MFMA16(kw, ones, nacc); } }
        float mean[4], rstd[4];
#pragma unroll
        for (int r = 0; r < 4; ++r) { const float inv = 1.f / fmaxf(fabsf(O[8][r]), __expf(-(bcr[r] + pmr[r]))); float s1 = 0.f;
#pragma unroll
            for (int ct = 0; ct < 8; ++ct) { O[ct][r] *= inv; s1 += O[ct][r]; }
            s1 = row16_sum(s1); mean[r] = s1 * (1.f / 128.f); float s2 = 0.f;
#pragma unroll
            for (int ct = 0; ct < 8; ++ct) { const float d = O[ct][r] - mean[r]; s2 += d * d; }
            s2 = row16_sum(s2); rstd[r] = rsqrtf(s2 * (1.f / 128.f) + EPSN); }
        WG_BAR_LDS();
#pragma unroll
        for (int j = 0; j < 4; ++j)
#pragma unroll
            for (int r = 0; r < 4; ++r) { const unsigned row = 16 * kt + 4 * gq + r, col = 16 * (vt0 + j) + mq;
                *(LAS bf16*)(TS + offb(row, col >> 3) + 2 * (col & 7)) = (bf16)f2bf(Cacc[j][r]); }
        if (w < 4) {
#pragma unroll
            for (int r = 0; r < 4; ++r) { const unsigned row = 16 * kt + 4 * gq + r;
                *(LAS bf16*)(TN + offb(row, mq >> 3) + 2 * (mq & 7)) = (bf16)f2bf(nacc[r]); } }
        { LAS unsigned char* st = TQK + 4096 * w;
#pragma unroll
          for (int ct = 0; ct < 8; ++ct) { const float gv = gn[16 * ct + mq];
#pragma unroll
            for (int r = 0; r < 4; ++r) *(LAS bf16*)(st + (4 * gq + r) * 256 + (16 * ct + mq) * 2) = (bf16)f2bf((O[ct][r] - mean[r]) * rstd[r] * gv); }
          LDS_WAIT(); asm volatile("" ::: "memory");
#pragma unroll 1
          for (int i = 0; i < 4; ++i) { const int n = lc + 64 * i, row = n >> 4, ch = n & 15;
            const v4u xv = *(LAS v4u*)(st + row * 256 + ch * 16);
            const size_t o = ((size_t)b * S + c * 128 + 16 * w + row) * 512 + h * 128 + ch * 8;
            const v4u gt = *(const GAS v4u*)(MO + o); v4u ov;
            { const float g0 = __uint_as_float(gt.x << 16), g1 = __uint_as_float(gt.x & 0xffff0000u); ov.x = pkbf(__uint_as_float(xv.x << 16) / (1.f + __expf(-g0)), __uint_as_float(xv.x & 0xffff0000u) / (1.f + __expf(-g1))); }
            { const float g0 = __uint_as_float(gt.y << 16), g1 = __uint_as_float(gt.y & 0xffff0000u); ov.y = pkbf(__uint_as_float(xv.y << 16) / (1.f + __expf(-g0)), __uint_as_float(xv.y & 0xffff0000u) / (1.f + __expf(-g1))); }
            { const float g0 = __uint_as_float(gt.z << 16), g1 = __uint_as_float(gt.z & 0xffff0000u); ov.z = pkbf(__uint_as_float(xv.z << 16) / (1.f + __expf(-g0)), __uint_as_float(xv.z & 0xffff0000u) / (1.f + __expf(-g1))); }
            { const float g0 = __uint_as_float(gt.w << 16), g1 = __uint_as_float(gt.w & 0xffff0000u); ov.w = pkbf(__uint_as_float(xv.w << 16) / (1.f + __expf(-g0)), __uint_as_float(xv.w & 0xffff0000u) / (1.f + __expf(-g1))); }
            *(GAS v4u*)(MV + o) = ov; }
        }
        WG_BAR_LDS();
    }
    WG_BAR_LDS();
}
__device__ __forceinline__ int t5_bucket(int d) {
    if (d < 16) return d;
    int b = 16;
    b += (d >= 19); b += (d >= 21); b += (d >= 24); b += (d >= 27); b += (d >= 31); b += (d >= 35); b += (d >= 40); b += (d >= 46);
    b += (d >= 52); b += (d >= 59); b += (d >= 67); b += (d >= 77); b += (d >= 87); b += (d >= 99); b += (d >= 113);
    return b;
}
__device__ __forceinline__ unsigned wave_incl_scan_u32(unsigned x) {
    int v = (int)x;
    v += __builtin_amdgcn_update_dpp(0, v, 0x111, 0xf, 0xf, true);
    v += __builtin_amdgcn_update_dpp(0, v, 0x112, 0xf, 0xf, true);
    v += __builtin_amdgcn_update_dpp(0, v, 0x114, 0xf, 0xf, true);
    v += __builtin_amdgcn_update_dpp(0, v, 0x118, 0xf, 0xf, true);
    v += __builtin_amdgcn_update_dpp(0, v, 0x142, 0xa, 0xf, false);
    v += __builtin_amdgcn_update_dpp(0, v, 0x143, 0xc, 0xf, false);
    return (unsigned)v;
}
__device__ __forceinline__ float relu0(float x) { const int b = __builtin_bit_cast(int, x); return __builtin_bit_cast(float, b > 0 ? b : 0); }
__device__ __forceinline__ unsigned fkey(float f) { const unsigned u = __float_as_uint(f); return u ^ ((unsigned)((int)u >> 31) | 0x80000000u); }
__device__ __forceinline__ void dsa_phase(Frame& F, int l) {
    const int lane = (opaque((int)threadIdx.x) & 63), w = F.wave;
    LAS float* s_q = (LAS float*)(F.lds + w * 13312);
    LAS unsigned* s_qb = (LAS unsigned*)s_q;
    LAS float* s_p = s_q + 1024;
    LAS int* s_sel = (LAS int*)(s_p + 2048);
    const bf16* QIDX = wsb(F, WS_QIDX); const bf16* KIDXN = wsb(F, WS_KIDXN); bf16* QLAT = wsb(F, WS_QLAT); const bf16* CKVN = wsb(F, WS_CKVN);
    const float* WIDX = (const float*)(F.ws + WS_WIDX); const float* rel_bias = ain(1);
    LAS unsigned char* img = (LAS unsigned char*)s_p; LAS float* s_red = s_q + 512; LAS unsigned char* s_out = (LAS unsigned char*)s_p;
    const int g4 = lane >> 4, m16 = lane & 15, hd = m16 & 7;
    LAS float* s_bd = (LAS float*)(F.lds + LDSCTL_OFF + 1024);
    for (int i = lane; i < 1024; i += 64) s_bd[i] = rel_bias[t5_bucket(i >> 3) * 8 + (i & 7)] * 1.4426950408889634f;
    float bmax = 0.f;
    for (int k = 0; k < 32; ++k) bmax = fmaxf(bmax, fabsf(rel_bias[k * 8 + hd]));
    float gmax = fmaxf(fabsf(ain(13)[l * 128 + lane]), fabsf(ain(13)[l * 128 + 64 + lane]));
    s_red[lane] = gmax; LDS_WAIT(); asm volatile("" ::: "memory");
    for (int k = 0; k < 64; ++k) gmax = fmaxf(gmax, s_red[k]);
    const float BKV = 1.01f * 11.313708498984761f * gmax;
    LDS_WAIT(); asm volatile("" ::: "memory");
    const bf16x8 ones = (bf16x8){0x3f80, 0x3f80, 0x3f80, 0x3f80, 0x3f80, 0x3f80, 0x3f80, 0x3f80};
    gu32* ctr = (gu32*)(F.ws + WS_CTL) + 16 + l;
    LAS unsigned* hist = (LAS unsigned*)s_q;
    LAS int* s_selB = (LAS int*)(s_q + 256);
    LAS unsigned* s_keyB = (LAS unsigned*)img;
    LAS unsigned char* kring = F.lds + 8 * 13312;
    LAS unsigned* s_tk = (LAS unsigned*)(F.lds + LDSCTL_OFF + 5120);
    for (;;) {
        WG_BAR_LDS();
        if (opaque((int)threadIdx.x) == 0) *s_tk = __hip_atomic_fetch_add(ctr, 1u, RLX_AGENT);
        WG_BAR_LDS();
        const unsigned tk = (unsigned)__builtin_amdgcn_readfirstlane((int)*s_tk);
        if (tk >= (unsigned)(M / 16)) break;
        const int tkk = M / 16 - 1 - (int)tk, bb = tkk & 15, P = tkk >> 4, tA = 16 * P + 2 * w + 1, tB = tA - 1, rowA = bb * 2048 + tA, rowB = rowA - 1;
        bf16x8 qA[2]; float wr[4];
        { const int rq = (m16 < 8) ? rowA : rowB;
#pragma unroll
          for (int s2 = 0; s2 < 2; ++s2) qA[s2] = __builtin_bit_cast(bf16x8, *(const GAS v4u*)(QIDX + (size_t)rq * 512 + hd * 64 + 32 * s2 + 8 * g4));
          const int rw = (g4 < 2) ? rowA : rowB;
#pragma unroll
          for (int r = 0; r < 4; ++r) wr[r] = WIDX[(size_t)rw * 8 + 4 * (g4 & 1) + r]; }
        LAS float* scr = s_q + 256;
        unsigned key[32];
        const int nj = ((16 * P + 15) >> 6) + 1;
#define DSA_KDMA(jj) __builtin_amdgcn_global_load_lds((const unsigned*)((const char*)(KIDXN + ((size_t)bb * S + 64 * (jj)) * 64) + 128 * (16 * (w >> 1) + m16) + 64 * (w & 1) + 16 * g4), \
                                                      (LAS unsigned*)(kring + ((jj) % 3) * 8192 + w * 1024), 16, 0, 0)
        DSA_KDMA(0); if (nj > 1) DSA_KDMA(1);
#pragma unroll
        for (int j = 0; j < 32; ++j) {
            key[j] = 0u;
            if (j < nj) {
                if (j + 1 < nj) asm volatile("s_waitcnt vmcnt(1)" ::: "memory"); else asm volatile("s_waitcnt vmcnt(0)" ::: "memory");
                __builtin_amdgcn_s_barrier();
                asm volatile("" ::: "memory");
                if (j + 2 < nj) DSA_KDMA(j + 2);
                v4u kfr[4][2];
#pragma unroll
                for (int bq = 0; bq < 4; ++bq)
#pragma unroll
                    for (int s2 = 0; s2 < 2; ++s2) kfr[bq][s2] = *(const LAS v4u*)(kring + (j % 3) * 8192 + (bq * 2 + s2) * 1024 + lane * 16);
                float part[4]; f32x4 ab[4];
#pragma unroll
                for (int bq = 0; bq < 4; ++bq) ab[bq] = MFMA16(qA[0], __builtin_bit_cast(bf16x8, kfr[bq][0]), ((f32x4){0.f, 0.f, 0.f, 0.f}));
#pragma unroll
                for (int bq = 0; bq < 4; ++bq) ab[bq] = MFMA16(qA[1], __builtin_bit_cast(bf16x8, kfr[bq][1]), ab[bq]);
#pragma unroll
                for (int bq = 0; bq < 4; ++bq) part[bq] = (wr[0] * relu0(ab[bq][0]) + wr[1] * relu0(ab[bq][1])) + (wr[2] * relu0(ab[bq][2]) + wr[3] * relu0(ab[bq][3]));
#pragma unroll
                for (int bq = 0; bq < 4; ++bq) { const auto s = __builtin_amdgcn_permlane16_swap(__float_as_uint(part[bq]), __float_as_uint(part[bq]), false, false);
                    part[bq] = __uint_as_float(s[0]) + __uint_as_float(s[1]); }
                const auto r02 = __builtin_amdgcn_permlane32_swap(__float_as_uint(part[0]), __float_as_uint(part[2]), false, false);
                const auto r13 = __builtin_amdgcn_permlane32_swap(__float_as_uint(part[1]), __float_as_uint(part[3]), false, false);
                const float scA = __uint_as_float((g4 & 1) ? r13[0] : r02[0]), scB = __uint_as_float((g4 & 1) ? r13[1] : r02[1]);
                if (lane + 64 * j <= tA) key[j] = fkey(scA);
                s_keyB[64 * j + lane] = (lane + 64 * j <= tB) ? fkey(scB) : 0u;
            }
        }
        int nselA = 0, nselB = 0;
#define DSA_SELECT(NJ) { \
            if (qi) { \
                asm volatile("s_waitcnt lgkmcnt(0)" ::: "memory"); \
                _Pragma("unroll") \
                for (int j = 0; j < NJ; ++j) key[j] = (j < nj) ? s_keyB[64 * j + lane] : 0u; } \
            unsigned T = 0u; int need = 0; bool exact = false; \
            const bool all = (tq + 1 <= 256); \
            if (!all) {                                            \
                unsigned prefix = 0u; int r = 256;                 \
                _Pragma("unroll 1") \
                for (int pass = 0; pass < 4; ++pass) { \
                    const int sh = 24 - 8 * pass; \
                    *(LAS v4u*)(hist + 4 * lane) = (v4u){0u, 0u, 0u, 0u}; \
                    _Pragma("unroll") \
                    for (int j = 0; j < NJ; ++j) { const unsigned k = key[j]; \
                        if (pass == 0 || (k >> (sh + 8)) == prefix) (void)__hip_atomic_fetch_add(hist + ((k >> sh) & 255u), 1u, __ATOMIC_RELAXED, __HIP_MEMORY_SCOPE_WORKGROUP); } \
                    const v4u h = *(const LAS v4u*)(hist + 4 * lane);                \
                    const unsigned inc = wave_incl_scan_u32(h.x + h.y + h.z + h.w); \
                    const unsigned U = (unsigned)__builtin_amdgcn_readlane((int)inc, 63) - inc;     \
                    const unsigned s3 = U + h.w, s2 = s3 + h.z, s1 = s2 + h.y, s0 = s1 + h.x;       \
                    const unsigned ur = (unsigned)r; \
                    const int Lh = 63 - __clzll(__ballot(s0 >= ur));                   \
                    const int isel = (s3 >= ur) ? 3 : ((s2 >= ur) ? 2 : ((s1 >= ur) ? 1 : 0)); \
                    const unsigned hsel = isel == 3 ? h.w : (isel == 2 ? h.z : (isel == 1 ? h.y : h.x)), ssel = isel == 3 ? s3 : (isel == 2 ? s2 : (isel == 1 ? s1 : s0)); \
                    const unsigned dL = 4u * (unsigned)Lh + (unsigned)__builtin_amdgcn_readlane(isel, Lh); \
                    const unsigned hL = (unsigned)__builtin_amdgcn_readlane((int)hsel, Lh), sL = (unsigned)__builtin_amdgcn_readlane((int)ssel, Lh); \
                    prefix = (prefix << 8) | dL; \
                    r -= (int)(sL - hL);                                               \
                    T = prefix << sh; \
                    if ((int)hL == r) { exact = true; break; }                         \
                } \
                if (!exact) need = r;                                                  \
            } \
            int running = 0, eqrun = 0; \
            const unsigned long long lt = (1ull << lane) - 1ull; \
            if (all) {                                             \
                _Pragma("unroll") \
                for (int j = 0; j < NJ; ++j) { \
                    const int s = lane + 64 * j; \
                    const bool take = (s <= tq); \
                    const unsigned long long mt = __ballot(take); \
                    const int pos = running + __popcll(mt & lt); \
                    if (take) selp[pos] = s; \
                    running += __popcll(mt); \
                } \
            } else if (exact) {                                    \
                _Pragma("unroll") \
                for (int j = 0; j < NJ; ++j) { \
                    const bool take = key[j] >= T; \
                    const unsigned long long mt = __ballot(take); \
                    const int pos = running + __popcll(mt & lt); \
                    if (take) selp[pos] = lane + 64 * j; \
                    running += __popcll(mt); \
                } \
            } else \
            _Pragma("unroll") \
            for (int j = 0; j < NJ; ++j) { \
                const int s = lane + 64 * j; \
                const bool valid = (s <= tq); \
                const bool is_eq = valid && !all && key[j] == T; \
                const unsigned long long meq = __ballot(is_eq); \
                const int rank_eq = eqrun + __popcll(meq & lt); \
                const bool take = valid && (all || (exact ? key[j] >= T : (key[j] > T || (is_eq && rank_eq < need)))); \
                const unsigned long long mt = __ballot(take); \
                const int pos = running + __popcll(mt & lt); \
                if (take) selp[pos] = s; \
                running += __popcll(mt); eqrun += __popcll(meq); \
            } \
            if (qi) nselB = running; else nselA = running; }
#pragma unroll 1
        for (int qi = 0; qi < 2; ++qi) {
            const int tq = qi ? tB : tA; LAS int* selp = qi ? s_selB : s_sel;
            if (nj <= 16) { if (nj <= 8) { if (nj <= 4) DSA_SELECT(4) else DSA_SELECT(8) } else { if (nj <= 12) DSA_SELECT(12) else DSA_SELECT(16) } }
            else { if (nj <= 24) { if (nj <= 20) DSA_SELECT(20) else DSA_SELECT(24) } else { if (nj <= 28) DSA_SELECT(28) else DSA_SELECT(32) } }
        }
#undef DSA_SELECT
#pragma unroll 1
        for (int qi = 0; qi < 2; ++qi) {
            const int tq = qi ? tB : tA, rowq = qi ? rowB : rowA, nselq = qi ? nselB : nselA; LAS int* selp = qi ? s_selB : s_sel;
        LDS_WAIT(); asm volatile("" ::: "memory");
            const int grow = lane >> 4, gch = lane & 15;
            const char* ckb = (const char*)(CKVN + (size_t)bb * S * 128);
            v4u nx[8];
#define ATT_GATHER(JP) { int kk[8]; _Pragma("unroll") for (int i = 0; i < 8; ++i) kk[i] = selp[(32 * (JP) + 4 * i + grow) & 255]; \
                if (32 * ((JP) + 1) > nselq) { _Pragma("unroll") for (int i = 0; i < 8; ++i) kk[i] = (32 * (JP) + 4 * i + grow < nselq) ? kk[i] : 0; }     \
                _Pragma("unroll") for (int i = 0; i < 8; ++i) nx[i] = *(const GAS v4u*)(ckb + ((unsigned)kk[i] * 256u + (unsigned)gch * 16u)); }
            ATT_GATHER(0)
            bf16x8 qB[4]; float ss = 0.f;
#pragma unroll
            for (int s4 = 0; s4 < 4; ++s4) { v4u q4 = (v4u){0u, 0u, 0u, 0u};
                if (m16 < 8) q4 = *(const GAS v4u*)(QLAT + (size_t)rowq * 1024 + m16 * 128 + 32 * s4 + 8 * g4);
                qB[s4] = __builtin_bit_cast(bf16x8, q4);
                const float a0 = __uint_as_float(q4.x << 16), a1 = __uint_as_float(q4.x & 0xffff0000u), a2 = __uint_as_float(q4.y << 16), a3 = __uint_as_float(q4.y & 0xffff0000u),
                            a4 = __uint_as_float(q4.z << 16), a5 = __uint_as_float(q4.z & 0xffff0000u), a6 = __uint_as_float(q4.w << 16), a7 = __uint_as_float(q4.w & 0xffff0000u);
                ss += (a0 * a0 + a1 * a1) + (a2 * a2 + a3 * a3) + (a4 * a4 + a5 * a5) + (a6 * a6 + a7 * a7); }
            s_red[lane] = ss; LDS_WAIT(); asm volatile("" ::: "memory");
            const float mh = sqrtf(s_red[m16] + s_red[m16 + 16] + s_red[m16 + 32] + s_red[m16 + 48]) * BKV + bmax;
            LDS_WAIT(); asm volatile("" ::: "memory");
            f32x4 O[9];
#pragma unroll
            for (int ct = 0; ct < 9; ++ct) O[ct] = (f32x4){0.f, 0.f, 0.f, 0.f};
            const int npr = (nselq + 31) >> 5;
#pragma unroll 1
            for (int jp = 0; jp < npr; ++jp) {
#pragma unroll
                for (int i = 0; i < 8; ++i) *(LAS v4u*)(img + offb2(4 * i + grow, gch)) = nx[i];
                if (jp + 1 < npr) ATT_GATHER(jp + 1)
                f32x4 pr[2];
#pragma unroll
                for (int hb = 0; hb < 2; ++hb) {
                    f32x4 a = (f32x4){-mh, -mh, -mh, -mh};
#pragma unroll
                    for (int s4 = 0; s4 < 4; ++s4) a = MFMA16(frag_row2(img, 16 * hb, s4, lane), qB[s4], a);
                    pr[hb] = a; }
#pragma unroll
                for (int hb = 0; hb < 2; ++hb) { const int sl0 = 32 * jp + 16 * hb + 4 * g4;
                    const v4u kr4 = *(const LAS v4u*)(selp + sl0);
#pragma unroll
                    for (int r = 0; r < 4; ++r) { const int dd = min(max(tq - (int)kr4[r], 0), 127);
                        pr[hb][r] = __builtin_amdgcn_exp2f(fmaf(pr[hb][r], 1.4426950408889634f, s_bd[dd * 8 + hd])); }
                    if (32 * (jp + 1) > nselq) {
#pragma unroll
                        for (int r = 0; r < 4; ++r) pr[hb][r] = (sl0 + r < nselq) ? pr[hb][r] : 0.f; } }
                const bf16x8 pf = pack_acc2(pr[0], pr[1]);
                asm volatile("s_waitcnt lgkmcnt(0)" ::: "memory");
                bf16x8 vf[8];
#pragma unroll
                for (int ct = 0; ct < 8; ++ct) vf[ct] = frag_tr2(img, 0, ct, lane);
                O[8] = MFMA16(pf, ones, O[8]);
#pragma unroll
                for (int ct = 0; ct < 8; ++ct) O[ct] = MFMA16(pf, vf[ct], O[ct]);
                asm volatile("s_waitcnt lgkmcnt(0)" ::: "memory");
            }
            if (g4 < 2) {
#pragma unroll
                for (int r = 0; r < 4; ++r) { const float inv = 1.f / O[8][r];
#pragma unroll
                    for (int ct = 0; ct < 8; ++ct) *(LAS bf16*)(s_out + (4 * g4 + r) * 256 + (16 * ct + m16) * 2) = (bf16)f2bf(O[ct][r] * inv); } }
            LDS_WAIT(); asm volatile("" ::: "memory");
#pragma unroll
            for (int i = 0; i < 2; ++i) { const int n = lane + 64 * i; *(GAS v4u*)(QLAT + (size_t)rowq * 1024 + n * 8) = *(LAS v4u*)(s_out + n * 16); }
            LDS_WAIT(); asm volatile("" ::: "memory");
        }
    }
}
__device__ __forceinline__ void final_norm(Frame& F) {
    const int gw = F.vcu * NWAVES + F.wave, NGW = F.G * NWAVES, lane = (opaque((int)threadIdx.x) & 63);
    const pg8::ssq_t ssq = ssq_arr(F, 12); const float* g = ain(2);
    f32x4 gv[4];
#pragma unroll
    for (int j = 0; j < 4; ++j) gv[j] = ((const f32x4*)g)[lane + 64 * j];
    for (int m0 = gw; m0 < M; m0 += 4 * NGW) {
        unsigned long long q[4][4]; float r[4];
#pragma unroll
        for (int i = 0; i < 4; ++i) { const int m = m0 + i * NGW; const GAS unsigned long long* xi = (const GAS unsigned long long*)(wsb(F, WS_XB) + (size_t)m * D) + lane;
#pragma unroll
            for (int j = 0; j < 4; ++j) q[i][j] = xi[64 * j];
            r[i] = rsqrtf(pg8::sget(ssq, m) * (1.f / 1024.f) + EPSN); }
#pragma unroll
        for (int i = 0; i < 4; ++i) { const int m = m0 + i * NGW; GAS f32x4* xo = (GAS f32x4*)(aout() + (size_t)m * D) + lane;
#pragma unroll
            for (int j = 0; j < 4; ++j) { const unsigned a = (unsigned)q[i][j], b = (unsigned)(q[i][j] >> 32);
                f32x4 v = (f32x4){__uint_as_float(a << 16), __uint_as_float(a & 0xffff0000u), __uint_as_float(b << 16), __uint_as_float(b & 0xffff0000u)}; v = v * r[i] * gv[j]; xo[64 * j] = v; } }
    }
}

__global__ void __launch_bounds__(NWAVES * 64, 2) hybrid_fwd(Args args) {
    extern __shared__ __attribute__((aligned(16))) unsigned char lds[];
    Frame F;
    F.lds = (LAS unsigned char*)lds;
        F.wave = __builtin_amdgcn_readfirstlane((int)threadIdx.x >> 6);
    F.G = gridDim.x; { const int bx = blockIdx.x; F.vcu = (F.G % 8 == 0) ? (bx % 8) * (F.G / 8) + bx / 8 : bx; }
    F.ws = aws();
    ASSUME_GLOBAL(F.ws);
    for (int u = threadIdx.x; u < (LDS_BYTES - LDSCTL_OFF) / 4; u += NWAVES * 64) ((LAS unsigned*)(F.lds + LDSCTL_OFF))[u] = 0u;
    __syncthreads();
    if (!MK_PER_PHASE) (void)xcd_barrier_post((unsigned*)((gu32*)(F.ws + WS_CTL) + CW_BAR), (volatile LAS unsigned*)(F.lds + MISC_OFF) + 8);
#ifdef PROBE_PHASE
    unsigned long long probe_acc = 0ull, probe_t0 = 0ull;
#define PROBE_BEGIN(k) do { if ((k) == PROBE_PHASE) probe_t0 = __builtin_amdgcn_s_memrealtime(); } while (0)
#define PROBE_END(k) do { if ((k) == PROBE_PHASE) probe_acc += __builtin_amdgcn_s_memrealtime() - probe_t0; } while (0)
#else
#define PROBE_BEGIN(k) do {} while (0)
#define PROBE_END(k) do {} while (0)
#endif
#define IN(k) (aint(216) <= (k) && (k) < aint(220))
#define GRID_BAR(k) do { if (IN(k) && IN((k) + 1)) { XcdBarrier bar_; { unsigned char* bw_ = F.ws; asm volatile("" : "+s"(bw_)); bar_.bar = (unsigned*)((gu32*)(bw_ + WS_CTL) + CW_BAR); } bar_.x = xb_xcc_id(); bar_.st = (volatile LAS unsigned*)(F.lds + MISC_OFF) + 8; xcd_barrier(bar_); } } while (0)

    PROBE_BEGIN(7); if (IN(0)) { p0_prologue(F); GRID_BAR(0); } PROBE_END(7);

    for (int l = 0; l < 2; ++l) {
        const int pb = 1 + 7 * l;
#define WL(off) ((const bf16*)(F.ws + WS_W + (size_t)lq * W_LAYER + (off)))
        if (IN(pb + 0) && PH_ON(0)) { PROBE_BEGIN(0); int lq = l; asm volatile("" : "+s"(lq));
            pg8::Gemm g{wsb(F, WS_XB), WL(W_IN), M, 4096, 1024}; pg8::StaticOrder So; So.init(M, 4096, F.G, opaque_s((int)blockIdx.x));
            pg8::EpiG1 E{F.ws, lq, ain(6) + lq * 4, ain(7) + lq * 4};
            pg8::gemm_phase<pg8::EpiG1, pg8::StaticOrder, true, true>(F.lds + RING_OFF, g, So, E);
            GRID_BAR(pb + 0); PROBE_END(0);
        }
        if (IN(pb + 1) && PH_ON(1)) { PROBE_BEGIN(1); int lq = l; asm volatile("" : "+s"(lq));
            p2_norms(F, lq);
            pg8::Gemm g{wsb(F, WS_CQ), WL(W_Q2), M, 1536, 256}; pg8::StaticOrder So; So.init(M, 1536, F.G, opaque_s((int)blockIdx.x));
            pg8::EpiQ2 E{F.ws, lq};
            pg8::gemm_phase<pg8::EpiQ2, pg8::StaticOrder, true, true>(F.lds + RING_OFF, g, So, E);
            GRID_BAR(pb + 1); PROBE_END(1);
        }
        if (IN(pb + 2) && PH_ON(2)) { PROBE_BEGIN(2); int lq = l; asm volatile("" : "+s"(lq));
            if (F.vcu < 128) { const int u = F.vcu >> 1;
                if (F.vcu & 1) retention_unit(F, lq, u >> 2, u & 3); else mlstm_unit(F, lq, u >> 2, u & 3); }
            dsa_phase(F, lq);
            GRID_BAR(pb + 2); PROBE_END(2);
        }
        if (IN(pb + 3) && PH_ON(3)) { PROBE_BEGIN(3); int lq = l; asm volatile("" : "+s"(lq));
            for (int br = 0; br < 3; ++br) {
                {
                    pg8::Gemm g{wsb(F, WS_XB), WL(W_G) + (size_t)br * 1024 * 1024, M, 1024, 1024}; pg8::StaticOrder So; So.init(M, 1024, F.G, opaque_s((int)blockIdx.x));
                    pg8::EpiGate E{F.ws, lq};
                    pg8::gemm_phase<pg8::EpiGate, pg8::StaticOrder, true, true>(F.lds + RING_OFF, g, So, E);
                }
                {
                    const bf16* A = wsb(F, br == 0 ? WS_MV : (br == 1 ? WS_QLAT : WS_RV));
                    const bf16* Bt = WL(br == 0 ? W_PM : (br == 1 ? W_AV : W_PR));
                    pg8::Gemm g{A, Bt, M, 1024, br == 1 ? 1024 : 512}; pg8::StaticOrder So; So.init(M, 1024, F.G, opaque_s((int)blockIdx.x));
                    pg8::EpiBr E{F.ws, br};
                    pg8::gemm_phase<pg8::EpiBr, pg8::StaticOrder, true, true>(F.lds + RING_OFF, g, So, E);
                }
            }
            GRID_BAR(pb + 3); PROBE_END(3);
        }
        if (IN(pb + 4) && PH_ON(4)) { PROBE_BEGIN(4); int lq = l; asm volatile("" : "+s"(lq));
            pg8::Gemm g{wsb(F, WS_Y), WL(W_OUT), M, 1024, 1024}; pg8::StaticOrder So; So.init(M, 1024, F.G, opaque_s((int)blockIdx.x));
            pg8::EpiRes E{F.ws, lq * 6 + 1};
            pg8::gemm_phase<pg8::EpiRes, pg8::StaticOrder, true, true>(F.lds + RING_OFF, g, So, E);
            GRID_BAR(pb + 4); PROBE_END(4);
        }
        if (IN(pb + 5) && PH_ON(5)) { PROBE_BEGIN(5); int lq = l; asm volatile("" : "+s"(lq));
            pg8::Gemm g{wsb(F, WS_XB), WL(W_GU), M, 5632, 1024}; pg8::StaticOrder So; So.init(M, 5632, F.G, opaque_s((int)blockIdx.x));
            pg8::EpiUp E{F.ws, lq};
            pg8::gemm_phase<pg8::EpiUp, pg8::StaticOrder, true, true>(F.lds + RING_OFF, g, So, E);
            GRID_BAR(pb + 5); PROBE_END(5);
        }
        if (IN(pb + 6) && PH_ON(6)) { PROBE_BEGIN(6); int lq = l; asm volatile("" : "+s"(lq));
            pg8::Gemm g{wsb(F, WS_HID), WL(W_DN), M, 1024, 2816}; pg8::StaticOrder So; So.init(M, 1024, F.G, opaque_s((int)blockIdx.x));
            pg8::EpiRes E{F.ws, lq == 0 ? 6 : 12};
            pg8::gemm_phase<pg8::EpiRes, pg8::StaticOrder, true, true>(F.lds + RING_OFF, g, So, E);
            GRID_BAR(pb + 6); PROBE_END(6);
        }
#undef WL
    }
    if (IN(15)) final_norm(F);
#ifdef PROBE_PHASE
    { const unsigned long long t1 = __builtin_amdgcn_s_memrealtime(); while (__builtin_amdgcn_s_memrealtime() - t1 < probe_acc) __builtin_amdgcn_s_sleep(8); }
#endif
#undef IN
#undef GRID_BAR
}

extern "C" void kernel_launch(void* const* d_in, const int* in_sizes, int n_in, void* d_out, int out_size, void* d_ws, size_t ws_size, hipStream_t stream) {
    static int grid = 0;
    if (grid == 0) {
        if (n_in != 25 || out_size != M * D || ws_size < WS_END) { fprintf(stderr, "kernel_launch: unexpected shapes / workspace (%d inputs, out %d, ws %zu)\n", n_in, out_size, ws_size); grid = -1; return; }
        int dev = 0, cus = 0, per_cu = 0;
        if (hipGetDevice(&dev) != hipSuccess || hipDeviceGetAttribute(&cus, hipDeviceAttributeMultiprocessorCount, dev) != hipSuccess) { grid = -1; return; }
        if (hipFuncSetAttribute((const void*)hybrid_fwd, hipFuncAttributeMaxDynamicSharedMemorySize, LDS_BYTES) != hipSuccess) { grid = -1; return; }
        if (hipOccupancyMaxActiveBlocksPerMultiprocessor(&per_cu, (const void*)hybrid_fwd, NWAVES * 64, LDS_BYTES) != hipSuccess || per_cu < 1) { fprintf(stderr, "kernel_launch: occupancy query says %d\n", per_cu); }
        (void)hipGetLastError();
        grid = cus;
    }
    if (grid < 0) return;
    if (hipMemsetAsync((char*)d_ws + WS_CTL, 0, CTL_ZERO_BYTES, stream) != hipSuccess) return;
    Args a{};
    for (int i = 0; i < 25; ++i) a.in[i] = (const float*)d_in[i];
    a.out = (float*)d_out; a.ws = (unsigned char*)d_ws;
#if MK_PER_PHASE
    for (int p = 0; p < N_PHASES; ++p) { a.ph_lo = p; a.ph_hi = p + 1; hipLaunchKernelGGL(hybrid_fwd, dim3(grid), dim3(NWAVES * 64), LDS_BYTES, stream, a); }
#else
    a.ph_lo = 0; a.ph_hi = N_PHASES;
    hipLaunchKernelGGL(hybrid_fwd, dim3(grid), dim3(NWAVES * 64), LDS_BYTES, stream, a);
#endif
}
```

```cpp
#include <hip/hip_runtime.h>
#include <cstdio>
#include <cstdint>
#include <math.h>
#if defined(__HIP_DEVICE_COMPILE__)
#define ASSUME_GLOBAL(p) __builtin_assume(!__builtin_amdgcn_is_shared(p) && !__builtin_amdgcn_is_private(p))
#else
#define ASSUME_GLOBAL(p) ((void)0)
#endif
constexpr int NWAVES = 8;
constexpr int D = 1024, NB = 16, S = 2048, M = NB * S, DIN = 7120, DFF = 2816;
constexpr int Z_MQ = 0, Z_MK = 256, Z_MV = 512, Z_MI = 1024, Z_MF = 1028, Z_MO = 1032, Z_CQ = 1544, Z_KIDX = 1800, Z_WIDX = 1864,
              Z_CKV = 1872, Z_RQ = 2000, Z_RK = 2512, Z_RV = 3024, Z_RG = 3536, Z_GM = 4048;
constexpr float EPSN = 1e-6f;
#ifndef MK_PER_PHASE
#define MK_PER_PHASE 0
#endif
#ifndef ONLY_PHASE
#define ONLY_PHASE -1
#endif
#define PH_ON(k) (ONLY_PHASE < 0 || ONLY_PHASE == (k))
constexpr int N_PHASES = 16;

constexpr size_t MiB = 1u << 20;
constexpr size_t WS_CTL = 0, CTL_ZERO_BYTES = 4 * MiB;
constexpr size_t WS_ROT = 79 * MiB;
constexpr size_t WS_W = 4 * MiB;
constexpr size_t W_IN = 0, W_G = W_IN + (size_t)4096 * 1024 * 2, W_Q2 = W_G + (size_t)3072 * 1024 * 2, W_PM = W_Q2 + (size_t)1536 * 256 * 2, W_PR = W_PM + (size_t)1024 * 512 * 2,
                 W_AV = W_PR + (size_t)1024 * 512 * 2, W_OUT = W_AV + (size_t)1024 * 1024 * 2, W_GU = W_OUT + (size_t)1024 * 1024 * 2, W_DN = W_GU + (size_t)5632 * 1024 * 2,
                 W_LAYER = W_DN + (size_t)1024 * 2816 * 2;
static_assert(WS_W + 2 * W_LAYER <= 79 * MiB, "weights fit");
constexpr size_t WS_XB = 80 * MiB, WS_QLAT = 144 * MiB, WS_MV = 208 * MiB, WS_RV = 240 * MiB, WS_QIDX = 272 * MiB, WS_CKVN = 304 * MiB, WS_KIDXN = 312 * MiB, WS_MQK = 316 * MiB,
                 WS_MO = 348 * MiB, WS_RG = 380 * MiB, WS_RQ = 412 * MiB, WS_RK = 444 * MiB, WS_CQ = 476 * MiB, WS_CKV = 492 * MiB, WS_KIDX = 500 * MiB, WS_MIF = 504 * MiB, WS_WIDX = 505 * MiB,
                 WS_END = 506 * MiB;
constexpr size_t WS_YACC = 272 * MiB, WS_G8 = 336 * MiB, WS_Y = 400 * MiB;
constexpr size_t WS_HID = 144 * MiB;
constexpr int CW_TMO = 0, CW_BAR = 4096;
constexpr size_t SSQ_OFF = 64 * 1024, SSQ_STRIDE = 256 * 1024;
static_assert(SSQ_OFF + 13 * SSQ_STRIDE <= CTL_ZERO_BYTES, "ssq arrays inside the memset region");
constexpr int RING_OFF = 0, RING_BYTES = 131072, LDSCTL_OFF = RING_BYTES, MISC_OFF = LDSCTL_OFF + 320, LDS_BYTES = 147456;

namespace pg8 {
#define PG8_LAS __attribute__((address_space(3)))
typedef unsigned short bf16_t;
typedef short bf16x8 __attribute__((ext_vector_type(8)));
typedef float f32x4 __attribute__((ext_vector_type(4)));
typedef unsigned u32x4 __attribute__((ext_vector_type(4)));
typedef unsigned u32x2 __attribute__((ext_vector_type(2)));
constexpr int BM = 256, BK = 64, HALF = 128, HTB = HALF * BK * 2  , STAGE_BYTES = 8 * HTB, NXCD = 8, WGM = 8;

__host__ __device__ __forceinline__ int lds_byte(int r, int c) { const int st = (r >> 4) * 2 + (c >> 5), rr = r & 15, cc = c & 31, ob = rr * 64 + cc * 2; return st * 1024 + (ob ^ (((ob >> 9) & 1) << 5)); }
__host__ __device__ __forceinline__ void stage_rc(int b, int& R, int& C) { const int st = b / 1024, sb = b % 1024, swz = sb ^ (((sb >> 9) & 1) << 5); R = (st >> 1) * 16 + swz / 64; C = (st & 1) * 32 + (swz % 64) / 2; }
__host__ __device__ __forceinline__ int perm32(int rho) { const int n = rho >> 4, i = rho & 15; return 8 * (i >> 2) + 4 * n + (i & 3); }

struct Unit { int pm, pn; };
struct Gemm { const bf16_t* A; const bf16_t* Bt; int M, N, K; };

struct StaticOrder {
    int nM, nN, nwg, G, c;
    __host__ __device__ void init(int M, int N, int G_, int c_) { nM = M / BM; nN = N / BM; nwg = nM * nN; G = G_; c = c_; }
    __host__ __device__ bool next(int i, Unit& u) const {
        const long L = (long)i * G + c; if (L >= nwg) return false;
        int wgid = (int)L; { const int q = nwg / NXCD, r = nwg % NXCD, xcd = wgid % NXCD, off = wgid / NXCD; wgid = (xcd < r ? xcd * (q + 1) : r * (q + 1) + (xcd - r) * q) + off; }
        const int nig = WGM * nN, gid = wgid / nig, fm = gid * WGM, gsz = (nM - fm) < WGM ? (nM - fm) : WGM;
        u.pm = fm + ((wgid % nig) % gsz); u.pn = (wgid % nig) / gsz; return true;
    }
    __device__ __forceinline__ void a_ready(const Unit&) const {}
    __device__ __forceinline__ void done(const Unit&) const {}
};
__device__ __forceinline__ unsigned cvt_pk_bf16(float lo, float hi) { unsigned r; asm volatile("v_cvt_pk_bf16_f32 %0, %1, %2" : "=v"(r) : "v"(lo), "v"(hi)); return r; }
constexpr float NEPS = 1e-6f;
__device__ __forceinline__ u32x4 pack8(const f32x4& a, const f32x4& b) { u32x4 w; w.x = cvt_pk_bf16(a[0], a[1]); w.y = cvt_pk_bf16(a[2], a[3]); w.z = cvt_pk_bf16(b[0], b[1]); w.w = cvt_pk_bf16(b[2], b[3]); return w; }
__device__ __forceinline__ float sum4sq(const f32x4& a) { return (a[0] * a[0] + a[1] * a[1]) + (a[2] * a[2] + a[3] * a[3]); }
__device__ __forceinline__ float sum4(const f32x4& a) { return (a[0] + a[1]) + (a[2] + a[3]); }
__device__ __forceinline__ float red_fq(float s) { s += __shfl_xor(s, 16); s += __shfl_xor(s, 32); return s; }
__device__ __forceinline__ float fsigmoid(float x) { return __builtin_amdgcn_rcpf(1.f + __expf(-x)); }
typedef float pk_f32x2 __attribute__((ext_vector_type(2)));
typedef __bf16 pk_bf16x2 __attribute__((ext_vector_type(2)));
__device__ __forceinline__ unsigned cvt_pk_bf16v(float a, float b) { const pk_f32x2 v = {a, b}; return __builtin_bit_cast(unsigned, __builtin_convertvector(v, pk_bf16x2)); }
__device__ __forceinline__ u32x4 pack8v(const f32x4& a, const f32x4& b) { u32x4 w; w.x = cvt_pk_bf16v(a[0], a[1]); w.y = cvt_pk_bf16v(a[2], a[3]); w.z = cvt_pk_bf16v(b[0], b[1]); w.w = cvt_pk_bf16v(b[2], b[3]); return w; }
__device__ __forceinline__ f32x4 u8x4f(unsigned a) { return (f32x4){(float)(a & 0xffu), (float)((a >> 8) & 0xffu), (float)((a >> 16) & 0xffu), (float)(a >> 24)}; }
__device__ __forceinline__ f32x4 bf4_lo(unsigned a, unsigned b) { return (f32x4){__uint_as_float(a << 16), __uint_as_float(a & 0xffff0000u), __uint_as_float(b << 16), __uint_as_float(b & 0xffff0000u)}; }
__device__ __forceinline__ unsigned char* opq(unsigned char* p) { asm volatile("" : "+s"(p)); ASSUME_GLOBAL(p); return p; }
#define PG8_GAS __attribute__((address_space(1)))
typedef PG8_GAS long long* ssq_t;
__device__ __forceinline__ ssq_t ssqp(unsigned char* w, int k) { return (ssq_t)(w + WS_CTL + SSQ_OFF + (size_t)k * SSQ_STRIDE); }
__device__ __forceinline__ void gadd(ssq_t p, float v) { (void)__hip_atomic_fetch_add((PG8_GAS unsigned long long*)p, (unsigned long long)__float2ll_rn(v * 1048576.f), __ATOMIC_RELAXED, __HIP_MEMORY_SCOPE_AGENT); }
__device__ __forceinline__ float sget(ssq_t p, int row) { return (float)p[row] * (1.f / 1048576.f); }
#define EPI_ROWCOL(colexpr) int row0 = u.pm * BM + wr * 64 + fr, cl = (colexpr); asm volatile("" : "+v"(row0), "+v"(cl)); unsigned char* const w = opq(ws)

struct EpiG1 {
    static constexpr bool PERM = true, AFTER_DRAIN = false;
    unsigned char* ws; int l; const float* ibias; const float* fbias;
    __device__ __forceinline__ void operator()(const f32x4 (&acc)[2][2][4][2], const Unit& u, int wr, int wc, int fr, int fq) const {
        const int pn = u.pn; EPI_ROWCOL(wc * 32 + 8 * fq);
        const ssq_t ssq1 = ssqp(w, l * 6 + 0);
        if (pn == 7) {
            bf16_t* CKV = (bf16_t*)(w + WS_CKV); bf16_t* KIDX = (bf16_t*)(w + WS_KIDX); float* WIDX = (float*)(w + WS_WIDX); float* MIF = (float*)(w + WS_MIF);
            const ssq_t ssq_ckv = ssqp(w, l * 6 + 3); const ssq_t sum_kidx = ssqp(w, l * 6 + 4); const ssq_t ssq_kidx = ssqp(w, l * 6 + 5);
            f32x4 ib = (f32x4){0.f, 0.f, 0.f, 0.f}, fb = ib;
            if (wc == 2 && fq == 1) { ib = *(const PG8_GAS f32x4*)ibias; fb = *(const PG8_GAS f32x4*)fbias; }
#pragma unroll
            for (int ai = 0; ai < 2; ++ai)
#pragma unroll
                for (int m = 0; m < 4; ++m) {
                    const int row = row0 + ai * HALF + m * 16;
                    const float rstd = rsqrtf(sget(ssq1, row) * (1.f / 1024.f) + NEPS);
                    const f32x4 a0 = acc[ai][0][m][0] * rstd, a1 = acc[ai][0][m][1] * rstd, b0 = acc[ai][1][m][0] * rstd, b1 = acc[ai][1][m][1] * rstd;
                    *(PG8_GAS u32x4*)(CKV + (size_t)row * 128 + cl) = pack8(a0, a1);
                    const float ss = red_fq(sum4sq(a0) + sum4sq(a1));
                    if (fq == 0) gadd(ssq_ckv + row, ss);
                    if (wc < 2) {
                        *(PG8_GAS u32x4*)(KIDX + (size_t)row * 64 + cl) = pack8(b0, b1);
                        const float s1 = red_fq(sum4(b0) + sum4(b1)), s2 = red_fq(sum4sq(b0) + sum4sq(b1));
                        if (fq == 0) { gadd(sum_kidx + row, s1); gadd(ssq_kidx + row, s2); }
                    } else if (wc == 2) {
                        if (fq == 0) { *(PG8_GAS f32x4*)(WIDX + (size_t)row * 8) = b0 * 0.04419417382415922f; *(PG8_GAS f32x4*)(WIDX + (size_t)row * 8 + 4) = b1 * 0.04419417382415922f; }
                        if (fq == 1) { *(PG8_GAS f32x4*)(MIF + (size_t)row * 8) = b0 + ib; *(PG8_GAS f32x4*)(MIF + (size_t)row * 8 + 4) = b1 + fb; }
                    }
                }
            return;
        }
        if (pn >= 8 && pn < 12) {
            const bool isk = pn >= 10; bf16_t* dst = (bf16_t*)(w + (isk ? WS_RK : WS_RQ)); const int coff = 256 * ((pn - 8) & 1);
            const float* rot = (const float*)(w + WS_ROT);
            const float sc = isk ? 0.08838834764831845f : 1.f; const int i0 = 4 * (4 * wc + fq);
#pragma unroll
            for (int ai = 0; ai < 2; ++ai)
#pragma unroll
                for (int m = 0; m < 4; ++m) {
                    const int row = row0 + ai * HALF + m * 16, t = row & 2047;
                    const float rstd = rsqrtf(sget(ssq1, row) * (1.f / 1024.f) + NEPS) * sc;
                    const f32x4 cs = *(const PG8_GAS f32x4*)(rot + (size_t)t * 128 + i0), sn = *(const PG8_GAS f32x4*)(rot + (size_t)t * 128 + 64 + i0);
#pragma unroll
                    for (int bj = 0; bj < 2; ++bj) {
                        const f32x4 x1 = acc[ai][bj][m][0] * rstd, x2 = acc[ai][bj][m][1] * rstd;
                        const f32x4 o1 = x1 * cs - x2 * sn, o2 = x1 * sn + x2 * cs;
                        *(PG8_GAS u32x4*)(dst + (size_t)row * 512 + coff + bj * HALF + cl) = pack8(o1, o2);
                    }
                }
            return;
        }
        size_t boff; int ld = 512, coff;
        if (pn < 2) { boff = WS_MQK; coff = 256 * pn; } else if (pn < 4) { boff = WS_MV; coff = 256 * (pn - 2); } else if (pn < 6) { boff = WS_MO; coff = 256 * (pn - 4); }
        else if (pn == 6) { boff = WS_CQ; ld = 256; coff = 0; } else if (pn < 14) { boff = WS_RV; coff = 256 * (pn - 12); } else { boff = WS_RG; coff = 256 * (pn - 14); }
        bf16_t* base = (bf16_t*)(w + boff); const ssq_t ssq_cq = ssqp(w, l * 6 + 2);
#pragma unroll
        for (int ai = 0; ai < 2; ++ai)
#pragma unroll
            for (int m = 0; m < 4; ++m) {
                const int row = row0 + ai * HALF + m * 16;
                const float rstd = rsqrtf(sget(ssq1, row) * (1.f / 1024.f) + NEPS);
                float ss = 0.f;
#pragma unroll
                for (int bj = 0; bj < 2; ++bj) {
                    const f32x4 v0 = acc[ai][bj][m][0] * rstd, v1 = acc[ai][bj][m][1] * rstd;
                    *(PG8_GAS u32x4*)(base + (size_t)row * ld + coff + bj * HALF + cl) = pack8(v0, v1);
                    ss += sum4sq(v0) + sum4sq(v1);
                }
                if (pn == 6) { ss = red_fq(ss); if (fq == 0) gadd(ssq_cq + row, ss); }
            }
    }
};
struct EpiQ2 {
    static constexpr bool PERM = true, AFTER_DRAIN = false;
    unsigned char* ws; int l;
    __device__ __forceinline__ void operator()(const f32x4 (&acc)[2][2][4][2], const Unit& u, int wr, int wc, int fr, int fq) const {
        const int pn = u.pn; EPI_ROWCOL(wc * 32 + 8 * fq);
        const ssq_t ssq_cq = ssqp(w, l * 6 + 2);
        bf16_t* base = (bf16_t*)(w + (pn < 4 ? WS_QLAT : WS_QIDX)); const int ld = pn < 4 ? 1024 : 512, coff = pn < 4 ? 256 * pn : 256 * (pn - 4);
#pragma unroll
        for (int ai = 0; ai < 2; ++ai)
#pragma unroll
            for (int m = 0; m < 4; ++m) {
                const int row = row0 + ai * HALF + m * 16;
                const float rstd = rsqrtf(sget(ssq_cq, row) * (1.f / 256.f) + NEPS);
#pragma unroll
                for (int bj = 0; bj < 2; ++bj)
                    *(PG8_GAS u32x4*)(base + (size_t)row * ld + coff + bj * HALF + cl) = pack8(acc[ai][bj][m][0] * rstd, acc[ai][bj][m][1] * rstd);
            }
    }
};
struct EpiGate {
    static constexpr bool PERM = true, AFTER_DRAIN = false;
    unsigned char* ws; int l;
    __device__ __forceinline__ void operator()(const f32x4 (&acc)[2][2][4][2], const Unit& u, int wr, int wc, int fr, int fq) const {
        EPI_ROWCOL(u.pn * BM + wc * 32 + 8 * fq);
        const ssq_t ssq1 = ssqp(w, l * 6 + 0); unsigned char* G8 = w + WS_G8;
#pragma unroll
        for (int ai = 0; ai < 2; ++ai)
#pragma unroll
            for (int m = 0; m < 4; ++m) {
                const int row = row0 + ai * HALF + m * 16;
                const float rstd = rsqrtf(sget(ssq1, row) * (1.f / 1024.f) + NEPS);
#pragma unroll
                for (int bj = 0; bj < 2; ++bj) {
                    f32x4 v0 = acc[ai][bj][m][0] * rstd, v1 = acc[ai][bj][m][1] * rstd;
#pragma unroll
                    for (int j = 0; j < 4; ++j) { v0[j] = fsigmoid(v0[j]) * 255.f; v1[j] = fsigmoid(v1[j]) * 255.f; }
                    unsigned lo = 0u, hi = 0u;
                    lo = __builtin_amdgcn_cvt_pk_u8_f32(v0[0], 0, lo); lo = __builtin_amdgcn_cvt_pk_u8_f32(v0[1], 1, lo); lo = __builtin_amdgcn_cvt_pk_u8_f32(v0[2], 2, lo); lo = __builtin_amdgcn_cvt_pk_u8_f32(v0[3], 3, lo);
                    hi = __builtin_amdgcn_cvt_pk_u8_f32(v1[0], 0, hi); hi = __builtin_amdgcn_cvt_pk_u8_f32(v1[1], 1, hi); hi = __builtin_amdgcn_cvt_pk_u8_f32(v1[2], 2, hi); hi = __builtin_amdgcn_cvt_pk_u8_f32(v1[3], 3, hi);
                    *(PG8_GAS u32x2*)(G8 + (unsigned)(row * 1024 + cl + bj * HALF)) = (u32x2){lo, hi};
                }
            }
    }
};
struct EpiBr {
    static constexpr bool PERM = true, AFTER_DRAIN = false;
    unsigned char* ws; int mode;
    __device__ __forceinline__ void operator()(const f32x4 (&acc)[2][2][4][2], const Unit& u, int wr, int wc, int fr, int fq) const {
        EPI_ROWCOL(u.pn * BM + wc * 32 + 8 * fq);
        const unsigned char* G8 = w + WS_G8; bf16_t* Y = (bf16_t*)(w + WS_Y); bf16_t* YACC = (bf16_t*)(w + WS_YACC);
#pragma unroll
        for (int ai = 0; ai < 2; ++ai)
#pragma unroll
            for (int m = 0; m < 4; ++m) {
                const int row = row0 + ai * HALF + m * 16;
#pragma unroll
                for (int bj = 0; bj < 2; ++bj) {
                    const unsigned o = (unsigned)(row * 1024 + cl + bj * HALF), ob = 2u * o;
                    const u32x2 g = *(const PG8_GAS u32x2*)(G8 + o);
                    f32x4 v0 = acc[ai][bj][m][0] * (u8x4f(g.x) * (1.f / 255.f)), v1 = acc[ai][bj][m][1] * (u8x4f(g.y) * (1.f / 255.f));
                    if (mode != 0) { const u32x4 y = *(const PG8_GAS u32x4*)((const unsigned char*)YACC + ob); v0 += bf4_lo(y.x, y.y); v1 += bf4_lo(y.z, y.w); }
                    *(PG8_GAS u32x4*)((unsigned char*)(mode != 2 ? YACC : Y) + ob) = pack8(v0, v1);
                }
            }
    }
};
struct EpiRes {
    static constexpr bool PERM = true, AFTER_DRAIN = false;
    unsigned char* ws; int kss;
    __device__ __forceinline__ void operator()(const f32x4 (&acc)[2][2][4][2], const Unit& u, int wr, int wc, int fr, int fq) const {
        EPI_ROWCOL(u.pn * BM + wc * 32 + 8 * fq);
        bf16_t* XB = (bf16_t*)(w + WS_XB); const ssq_t ssq_next = ssqp(w, kss);
#pragma unroll
        for (int ai = 0; ai < 2; ++ai)
#pragma unroll
            for (int m = 0; m < 4; ++m) {
                const int row = row0 + ai * HALF + m * 16;
                float ss = 0.f;
#pragma unroll
                for (int bj = 0; bj < 2; ++bj) {
                    const unsigned ob = 2u * (unsigned)(row * 1024 + cl + bj * HALF);
                    const u32x4 xo = *(const PG8_GAS u32x4*)((const unsigned char*)XB + ob);
                    const f32x4 v0 = acc[ai][bj][m][0] + bf4_lo(xo.x, xo.y), v1 = acc[ai][bj][m][1] + bf4_lo(xo.z, xo.w);
                    *(PG8_GAS u32x4*)((unsigned char*)XB + ob) = pack8(v0, v1);
                    ss += sum4sq(v0) + sum4sq(v1);
                }
                ss = red_fq(ss); if (fq == 0) gadd(ssq_next + row, ss);
            }
    }
};
struct EpiUp {
    static constexpr bool PERM = true, AFTER_DRAIN = false;
    unsigned char* ws; int l;
    __device__ __forceinline__ void operator()(const f32x4 (&acc)[2][2][4][2], const Unit& u, int wr, int wc, int fr, int fq) const {
        EPI_ROWCOL(u.pn * HALF + wc * 32 + 8 * fq);
        const ssq_t ssq2 = ssqp(w, l * 6 + 1); bf16_t* HID = (bf16_t*)(w + WS_HID);
#pragma unroll
        for (int ai = 0; ai < 2; ++ai)
#pragma unroll
            for (int m = 0; m < 4; ++m) {
                const int row = row0 + ai * HALF + m * 16;
                const float rstd = rsqrtf(sget(ssq2, row) * (1.f / 1024.f) + NEPS);
                f32x4 h[2];
#pragma unroll
                for (int n = 0; n < 2; ++n) {
                    const f32x4 g = acc[ai][0][m][n] * rstd, up = acc[ai][1][m][n] * rstd;
#pragma unroll
                    for (int j = 0; j < 4; ++j) h[n][j] = g[j] * fsigmoid(g[j]) * up[j];
                }
                *(PG8_GAS u32x4*)((unsigned char*)HID + 2u * (unsigned)(row * 2816 + cl)) = pack8(h[0], h[1]);
            }
    }
};

template <class Epi, class Sched, bool ALIGN_EPI = false, bool SP2 = false>
__device__ __forceinline__ void gemm_phase(PG8_LAS unsigned char* lds, const Gemm g, const Sched& S, const Epi& E) {
    int tid_ = threadIdx.x; asm volatile("" : "+v"(tid_));
    const int tid = tid_, wid = __builtin_amdgcn_readfirstlane(tid >> 6), lane = tid & 63, wr = wid >> 2, wc = wid & 3, fr = lane & 15, fq = lane >> 4;
    int K_ = __builtin_amdgcn_readfirstlane(g.K); asm volatile("" : "+s"(K_));
    const int K = K_, nt = K / BK;
    unsigned voffA[2], voffB[2];
#pragma unroll
    for (int i = 0; i < 2; ++i) { int R, C; stage_rc(tid * 16 + i * 8192, R, C); const int Rb = Epi::PERM ? ((R & ~31) + perm32(R & 31)) : R;
        voffA[i] = (unsigned)(R * K + C) * 2u; voffB[i] = (unsigned)(Rb * K + C) * 2u; }
    const size_t kstep = (size_t)(BK * 2);
    const size_t hstep = (size_t)HALF * K * 2;
    const size_t tstep = 2 * hstep;
    const unsigned ldsw = (unsigned)wid * 1024u;
    const int aoff = lds_byte(wr * 64 + fr, fq * 8), boff = lds_byte(wc * 32 + fr, fq * 8);
#define PG8_SA(b, h) (((b) * 2 + (h)) * HTB)
#define PG8_SB(b, h) ((4 + (b) * 2 + (h)) * HTB)
#define PG8_STAGE(bufoff, gbase, voff) do { const char* sb_ = (const char*)(gbase); asm volatile("" : "+s"(sb_)); _Pragma("unroll") for (int _i = 0; _i < 2; ++_i) \
        __builtin_amdgcn_global_load_lds((const unsigned*)(sb_ + (voff)[_i]), (PG8_LAS unsigned*)(lds + (bufoff) + ldsw + _i * 8192), 16, 0, 0); } while (0)
#define PG8_LDA(dst, b, h) do { _Pragma("unroll") for (int m = 0; m < 4; ++m) _Pragma("unroll") for (int k = 0; k < 2; ++k) dst[m][k] = *(const PG8_LAS bf16x8*)(lds + PG8_SA(b, h) + aoff + m * 2048 + k * 1024); } while (0)
#define PG8_LDB(dst, b, h) do { _Pragma("unroll") for (int n = 0; n < 2; ++n) _Pragma("unroll") for (int k = 0; k < 2; ++k) dst[n][k] = *(const PG8_LAS bf16x8*)(lds + PG8_SB(b, h) + boff + n * 2048 + k * 1024); } while (0)
#define PG8_MMA(ai, bj, At, Bt) do { __builtin_amdgcn_s_setprio(1); _Pragma("unroll") for (int m = 0; m < 4; ++m) _Pragma("unroll") for (int n = 0; n < 2; ++n) _Pragma("unroll") for (int k = 0; k < 2; ++k) \
        acc[ai][bj][m][n] = __builtin_amdgcn_mfma_f32_16x16x32_bf16(Bt[n][k], At[m][k], acc[ai][bj][m][n], 0, 0, 0); __builtin_amdgcn_s_setprio(0); } while (0)
#define PG8_WAIT_V(n) asm volatile("s_waitcnt vmcnt(" #n ")" ::: "memory")
#define PG8_WAIT_L(n) asm volatile("s_waitcnt lgkmcnt(" #n ")" ::: "memory")
#define PG8_BAR __builtin_amdgcn_s_barrier()
#define PG8_SCHED __builtin_amdgcn_sched_barrier(0)
    Unit cur, nxt; int ui = 0;
    if (!S.next(0, cur)) return;
    f32x4 acc[2][2][4][2];
#pragma unroll
    for (int a = 0; a < 2; ++a)
#pragma unroll
        for (int b = 0; b < 2; ++b)
#pragma unroll
            for (int m = 0; m < 4; ++m)
#pragma unroll
                for (int n = 0; n < 2; ++n) acc[a][b][m][n] = (f32x4){0.f, 0.f, 0.f, 0.f};
    bf16x8 At[4][2], B0[2][2], B1[2][2];
    const char* cA = (const char*)g.A + (size_t)cur.pm * tstep; const char* cB = (const char*)g.Bt + (size_t)cur.pn * tstep;
    S.a_ready(cur);
    if constexpr (SP2) {
        PG8_STAGE(PG8_SB(0, 0), cB, voffB); PG8_STAGE(PG8_SB(0, 1), cB + hstep, voffB); PG8_STAGE(PG8_SA(0, 0), cA, voffA); PG8_STAGE(PG8_SA(0, 1), cA + hstep, voffA);
        if (wr == 1) PG8_BAR;
        PG8_WAIT_V(2); PG8_BAR;
        PG8_STAGE(PG8_SB(1, 0), cB + kstep, voffB); PG8_STAGE(PG8_SA(1, 0), cA + kstep, voffA); PG8_STAGE(PG8_SB(1, 1), cB + hstep + kstep, voffB);
        PG8_WAIT_V(6); PG8_BAR;
    } else {
        PG8_STAGE(PG8_SB(0, 0), cB, voffB); PG8_STAGE(PG8_SA(0, 0), cA, voffA); PG8_STAGE(PG8_SB(0, 1), cB + hstep, voffB); PG8_STAGE(PG8_SA(0, 1), cA + hstep, voffA);
        if (wr == 1) PG8_BAR;
        PG8_WAIT_V(4); PG8_BAR;
        PG8_STAGE(PG8_SB(1, 0), cB + kstep, voffB); PG8_STAGE(PG8_SA(1, 0), cA + kstep, voffA); PG8_STAGE(PG8_SB(1, 1), cB + hstep + kstep, voffB);
        PG8_WAIT_V(6); PG8_BAR;
    }
    for (;;) {
        const bool has_next = S.next(ui + 1, nxt);
        const char* nA = has_next ? (const char*)g.A + (size_t)nxt.pm * tstep : cA; const char* nB = has_next ? (const char*)g.Bt + (size_t)nxt.pn * tstep : cB;
        for (int t = 0; t < nt; t += 2) {
            asm volatile("" : "+v"(voffA[0]), "+v"(voffA[1]), "+v"(voffB[0]), "+v"(voffB[1]));
            const bool last = (t == nt - 2);
            const char* a1 = cA + (size_t)(t + 1) * kstep;
            const char* a2 = last ? nA : cA + (size_t)(t + 2) * kstep; const char* b2 = last ? nB : cB + (size_t)(t + 2) * kstep;
            const char* a3 = a2 + kstep; const char* b3 = b2 + kstep;
            if (last && has_next) S.a_ready(nxt);
            if constexpr (SP2) {
            PG8_LDB(B0, 0, 0); PG8_LDB(B1, 0, 1); PG8_SCHED; PG8_LDA(At, 0, 0); PG8_STAGE(PG8_SA(1, 1), a1 + hstep, voffA);
            PG8_WAIT_V(8); PG8_WAIT_L(0); PG8_BAR; PG8_MMA(0, 0, At, B0); PG8_MMA(0, 1, At, B1); PG8_BAR; PG8_SCHED;
            PG8_LDA(At, 0, 1); PG8_STAGE(PG8_SB(0, 0), b2, voffB); PG8_STAGE(PG8_SB(0, 1), b2 + hstep, voffB); PG8_STAGE(PG8_SA(0, 0), a2, voffA);
            PG8_WAIT_V(8); PG8_WAIT_L(0); PG8_BAR; PG8_MMA(1, 0, At, B0); PG8_MMA(1, 1, At, B1); PG8_BAR; PG8_SCHED;
            PG8_LDB(B0, 1, 0); PG8_LDB(B1, 1, 1); PG8_SCHED; PG8_LDA(At, 1, 0); PG8_STAGE(PG8_SA(0, 1), a2 + hstep, voffA);
            PG8_WAIT_V(8); PG8_WAIT_L(0); PG8_BAR; PG8_MMA(0, 0, At, B0); PG8_MMA(0, 1, At, B1); PG8_BAR; PG8_SCHED;
            PG8_LDA(At, 1, 1); PG8_STAGE(PG8_SB(1, 0), b3, voffB); PG8_STAGE(PG8_SB(1, 1), b3 + hstep, voffB); PG8_STAGE(PG8_SA(1, 0), a3, voffA);
            PG8_WAIT_V(8); PG8_WAIT_L(0); PG8_BAR; PG8_MMA(1, 0, At, B0); PG8_MMA(1, 1, At, B1); PG8_BAR; PG8_SCHED;
            } else {
            PG8_LDB(B0, 0, 0); PG8_SCHED; PG8_LDA(At, 0, 0); PG8_STAGE(PG8_SA(1, 1), a1 + hstep, voffA);
            PG8_WAIT_L(8); PG8_BAR; PG8_WAIT_L(0); PG8_MMA(0, 0, At, B0); PG8_BAR; PG8_SCHED;
            PG8_LDB(B1, 0, 1); PG8_STAGE(PG8_SB(0, 0), b2, voffB);
            PG8_BAR; PG8_WAIT_L(0); PG8_MMA(0, 1, At, B1); PG8_BAR;
            PG8_LDA(At, 0, 1); PG8_STAGE(PG8_SA(0, 0), a2, voffA);
            PG8_BAR; PG8_WAIT_L(0); PG8_MMA(1, 0, At, B0); PG8_BAR; PG8_SCHED;
            PG8_STAGE(PG8_SB(0, 1), b2 + hstep, voffB);
            PG8_WAIT_V(6); PG8_BAR; PG8_MMA(1, 1, At, B1); PG8_BAR;
            PG8_LDB(B0, 1, 0); PG8_SCHED; PG8_LDA(At, 1, 0); PG8_STAGE(PG8_SA(0, 1), a2 + hstep, voffA);
            PG8_WAIT_L(8); PG8_BAR; PG8_WAIT_L(0); PG8_MMA(0, 0, At, B0); PG8_BAR; PG8_SCHED;
            PG8_LDB(B1, 1, 1); PG8_STAGE(PG8_SB(1, 0), b3, voffB);
            PG8_BAR; PG8_WAIT_L(0); PG8_MMA(0, 1, At, B1); PG8_BAR;
            PG8_LDA(At, 1, 1); PG8_STAGE(PG8_SA(1, 0), a3, voffA);
            PG8_BAR; PG8_WAIT_L(0); PG8_MMA(1, 0, At, B0); PG8_BAR; PG8_SCHED;
            PG8_STAGE(PG8_SB(1, 1), b3 + hstep, voffB);
            PG8_WAIT_V(6); PG8_BAR; PG8_MMA(1, 1, At, B1); PG8_BAR;
            }
        }
        if constexpr (ALIGN_EPI) { if (wr == 0) PG8_BAR; }
        if constexpr (!Epi::AFTER_DRAIN) { E(acc, cur, wr, wc, fr, fq); S.done(cur); }
        if (!has_next) break;
#pragma unroll
        for (int a = 0; a < 2; ++a)
#pragma unroll
            for (int b = 0; b < 2; ++b)
#pragma unroll
                for (int m = 0; m < 4; ++m)
#pragma unroll
                    for (int n = 0; n < 2; ++n) acc[a][b][m][n] = (f32x4){0.f, 0.f, 0.f, 0.f};
        cur = nxt; cA = nA; cB = nB; ++ui;
        if constexpr (ALIGN_EPI) { if (wr == 1) PG8_BAR; }
    }
    PG8_WAIT_V(0);
    if constexpr (!ALIGN_EPI) { if (wr == 0) PG8_BAR; }
    PG8_BAR;
    if constexpr (Epi::AFTER_DRAIN) { E.fused(acc, cur, wr, wc, fr, fq, lds, wid, lane); S.done(cur); }
#undef PG8_SA
#undef PG8_SB
#undef PG8_STAGE
#undef PG8_LDA
#undef PG8_LDB
#undef PG8_MMA
#undef PG8_WAIT_V
#undef PG8_WAIT_L
#undef PG8_BAR
#undef PG8_SCHED
}
}
#define GAS __attribute__((address_space(1)))
#define LAS __attribute__((address_space(3)))
typedef unsigned short bf16;
typedef unsigned v4u __attribute__((ext_vector_type(4)));
typedef float f32x4 __attribute__((ext_vector_type(4)));
typedef short bf16x8 __attribute__((ext_vector_type(8)));
typedef GAS unsigned gu32;
typedef GAS unsigned long long gu64;
#define RLX_AGENT __ATOMIC_RELAXED, __HIP_MEMORY_SCOPE_AGENT
#define LDS_WAIT() asm volatile("s_waitcnt lgkmcnt(0)" ::: "memory")
#define WG_BAR_LDS() do { asm volatile("s_waitcnt lgkmcnt(0)" ::: "memory"); __builtin_amdgcn_s_barrier(); asm volatile("" ::: "memory"); } while (0)
#define VM_WAIT() asm volatile("s_waitcnt vmcnt(0)" ::: "memory")
__device__ __forceinline__ unsigned long long rt() { return __builtin_amdgcn_s_memrealtime(); }
__device__ __forceinline__ unsigned f2bf(float f) { unsigned u = __builtin_bit_cast(unsigned, f); return (u + 0x7fffu + ((u >> 16) & 1u)) >> 16; }
__device__ __forceinline__ unsigned pk2(float lo, float hi) { return f2bf(lo) | (f2bf(hi) << 16); }

#define XB_TMO      128
#define XB_XCNT(j)  (256  + 64 * (j))
#define XB_XSUB(j)  (1280 + 64 * (j))
#define XB_XGEN(j)  (2304 + 64 * (j))
#define XB_TOP      3328
#define XB_TOPGEN   3392
#define XCD_BAR_WORDS 3456
#define XB_SPIN_CAP (1u << 18)

__device__ __forceinline__ unsigned xb_ld(unsigned* p)              { return __hip_atomic_load(p, __ATOMIC_RELAXED, __HIP_MEMORY_SCOPE_AGENT); }
__device__ __forceinline__ unsigned xb_add(unsigned* p, unsigned v) { return __hip_atomic_fetch_add(p, v, __ATOMIC_RELAXED, __HIP_MEMORY_SCOPE_AGENT); }
__device__ __forceinline__ unsigned xb_xcc_id() { return (unsigned)__builtin_amdgcn_s_getreg((3 << 11) | 20) & 0xFu; }
#define XB_SPIN(cond, bar) do { unsigned _sp = 0; while (cond) { __builtin_amdgcn_s_sleep(1); \
    if ((++_sp & 255u) == 0u) { if (xb_ld(&(bar)[XB_TMO])) break; if (_sp > XB_SPIN_CAP) { atomicAdd(&(bar)[XB_TMO], 1u); break; } } } } while (0)

struct XcdBarrier {
    unsigned* bar; unsigned x;
    volatile LAS unsigned* st;
};

__device__ __forceinline__ XcdBarrier xcd_barrier_post(unsigned* bar, volatile LAS unsigned* st) {
    XcdBarrier b; b.bar = bar; b.x = xb_xcc_id(); b.st = st;
    if (threadIdx.x == 0) (void)xb_add(&bar[XB_XCNT(b.x)], 1u);
    return b;
}
__device__ __forceinline__ void xcd_barrier_complete(unsigned* bar, unsigned x, unsigned& nloc, unsigned& nx) {
    const unsigned G = gridDim.x * gridDim.y * gridDim.z;
    unsigned sum, cnt, mine, sp = 0u;
    for (;;) {
        sum = 0u; cnt = 0u; mine = 0u;
#pragma unroll
        for (unsigned j = 0; j < 16; ++j) { const unsigned c = xb_ld(&bar[XB_XCNT(j)]); sum += c; cnt += (c > 0u) ? 1u : 0u; mine = (j == x) ? c : mine; }
        if (sum == G) break;
        __builtin_amdgcn_s_sleep(1);
        if ((++sp & 255u) == 0u) { if (xb_ld(&bar[XB_TMO])) break; if (sp > XB_SPIN_CAP) { atomicAdd(&bar[XB_TMO], 1u); break; } }
    }
    nloc = mine > 0u ? mine : 1u; nx = cnt > 0u ? cnt : 1u;
}

__device__ __forceinline__ void xcd_barrier(const XcdBarrier& b) {
    asm volatile("s_waitcnt vmcnt(0)" ::: "memory");
    __syncthreads();
    if (threadIdx.x == 0) {
        unsigned* bar = b.bar;
        __builtin_amdgcn_s_waitcnt(0);
        unsigned nloc = b.st[0], nx = b.st[1];
        if (nloc == 0u) { xcd_barrier_complete(bar, b.x, nloc, nx); b.st[0] = nloc; b.st[1] = nx; }
        const unsigned old = xb_add(&bar[XB_XSUB(b.x)], 1u);
        const unsigned gen = old / nloc;
        if (old + 1u == (gen + 1u) * nloc) {
            __builtin_amdgcn_fence(__ATOMIC_RELEASE, "agent");
            asm volatile("s_waitcnt vmcnt(0)" ::: "memory");
            const unsigned og = xb_add(&bar[XB_TOP], 1u);
            const unsigned tg = og / nx;
            if (og + 1u == (tg + 1u) * nx) xb_add(&bar[XB_TOPGEN], 1u);
            else XB_SPIN(xb_ld(&bar[XB_TOPGEN]) == tg, bar);
            __builtin_amdgcn_fence(__ATOMIC_ACQUIRE, "agent");
            xb_add(&bar[XB_XGEN(b.x)], 1u);
            asm volatile("s_waitcnt vmcnt(0)" ::: "memory");
        } else {
            XB_SPIN(xb_ld(&bar[XB_XGEN(b.x)]) == gen, bar);
            __builtin_amdgcn_fence(__ATOMIC_ACQUIRE, "agent");
            asm volatile("s_waitcnt vmcnt(0)" ::: "memory");
        }
    }
    __syncthreads();
}
struct Args { const float* in[25]; float* out; unsigned char* ws; int ph_lo, ph_hi; };
typedef __attribute__((address_space(4))) const unsigned char kbyte;
__device__ __forceinline__ kbyte* kargs() { kbyte* p = (kbyte*)__builtin_amdgcn_kernarg_segment_ptr(); asm volatile("" : "+s"(p)); return p; }
__device__ __forceinline__ const float* ain(int i) { const float* p = (const float*)*(GAS const float* __attribute__((address_space(4))) const*)(kargs() + 8 * i); ASSUME_GLOBAL(p); return p; }
__device__ __forceinline__ float* aout() { return (float*)*(GAS float* __attribute__((address_space(4))) const*)(kargs() + 200); }
__device__ __forceinline__ unsigned char* aws() { return (unsigned char*)*(GAS unsigned char* __attribute__((address_space(4))) const*)(kargs() + 208); }
__device__ __forceinline__ int aint(int off) { return *(const int __attribute__((address_space(4)))*)(kargs() + off); }
static_assert(sizeof(Args) == 224, "Args layout");
struct Frame {
    LAS unsigned char* lds;
    unsigned char* ws;
    int wave, vcu, G;
};
__device__ __forceinline__ pg8::ssq_t ssq_arr(const Frame& F, int k) { return pg8::ssqp(F.ws, k); }
__device__ __forceinline__ bf16* wsb(const Frame& F, size_t off) { return (bf16*)(F.ws + off); }
__device__ __forceinline__ float bf2f(bf16 v) { return __uint_as_float((unsigned)v << 16); }
__device__ __forceinline__ int opaque(int v) { asm volatile("" : "+v"(v)); return v; }
__device__ __forceinline__ int opaque_s(int v) { asm volatile("" : "+s"(v)); return v; }
__device__ __forceinline__ float wave_sum(float v) {
#pragma unroll
    for (int o = 1; o < 64; o <<= 1) v += __shfl_xor(v, o);
    return v;
}
__device__ __forceinline__ float wave_max(float v) {
#pragma unroll
    for (int o = 1; o < 64; o <<= 1) v = fmaxf(v, __shfl_xor(v, o));
    return v;
}

__device__ __forceinline__ int win_srccol(int n) {
    const int t = n >> 8, c = n & 255;
    switch (t) {
        case 0: return Z_MQ + c; case 1: return Z_MK + c; case 2: case 3: return Z_MV + (n - 512); case 4: case 5: return Z_MO + (n - 1024); case 6: return Z_CQ + c;
        case 7: if (c < 128) return Z_CKV + c; if (c < 192) return Z_KIDX + (c - 128); if (c < 200) return Z_WIDX + (c - 192); if (c < 204) return Z_MI + (c - 200); if (c < 208) return Z_MF + (c - 204); return -1;
        case 8: case 9: case 10: case 11: {
            const int base = (t < 10) ? Z_RQ : Z_RK, hh = 2 * (t & 1) + (c >> 7), p = c & 127, j8 = p >> 3, e = p & 7;
            return base + hh * 128 + ((e < 4) ? (4 * j8 + e) : (64 + 4 * j8 + (e - 4))); }
        case 12: case 13: return Z_RV + (n - 3072);
        default: return Z_RG + (n - 3584);
    }
}
__device__ __forceinline__ void tr_item(const float* p, int ld, const float* kscale, int K, bf16* WT, int k0, int n0, LAS float* scr, int lane) {
#pragma unroll
    for (int i = 0; i < 8; ++i) { const int kk = (lane >> 3) + 8 * i; f32x4 v = (f32x4){0.f, 0.f, 0.f, 0.f};
        if (p) { v = __builtin_nontemporal_load((const GAS f32x4*)(p + (size_t)(k0 + kk) * ld)); if (kscale) v = v * kscale[k0 + kk]; }
        LAS float* d = scr + kk * 33 + 4 * (lane & 7); d[0] = v.x; d[1] = v.y; d[2] = v.z; d[3] = v.w; }
    LDS_WAIT(); asm volatile("" ::: "memory");
    const int c = lane & 7;
#pragma unroll
    for (int j = 0; j < 4; ++j) { const int n = (lane >> 3) + 8 * j; const LAS float* s = scr + (8 * c) * 33 + n;
        v4u o; o.x = pk2(s[0 * 33], s[1 * 33]); o.y = pk2(s[2 * 33], s[3 * 33]); o.z = pk2(s[4 * 33], s[5 * 33]); o.w = pk2(s[6 * 33], s[7 * 33]);
        *(GAS v4u*)(WT + (size_t)(n0 + n) * K + k0 + 8 * c) = o; }
    LDS_WAIT(); asm volatile("" ::: "memory");
}
__device__ __forceinline__ void p0_prologue(Frame& F) {
    LAS float* scr = (LAS float*)(F.lds + RING_OFF + F.wave * 16384);
    const int gw = F.vcu * NWAVES + F.wave, NGW = F.G * NWAVES, lane = (opaque((int)threadIdx.x) & 63);
    constexpr int I_IN = 16 * 128, I_G = 16 * 96, I_Q2 = 4 * 16, I_PM = 8 * 32, I_PR = 8 * 32, I_OUT = 16 * 32, I_GU = 16 * 176, I_DN = 44 * 32;
    constexpr int I_LAYER = I_IN + I_G + I_Q2 + I_PM + I_PR + I_OUT + I_GU + I_DN;
    for (int it = gw; it < 2 * I_LAYER; it += NGW) {
        const int l = it / I_LAYER; int r = it % I_LAYER;
        unsigned char* wl = F.ws + WS_W + (size_t)l * W_LAYER;
        const float* w_in = ain(4) + (size_t)l * D * DIN;
        const int nl = 4 * (lane & 7);
        if (r < I_IN) { const int kb = r / 128, nb = r % 128, n = 32 * nb + nl, sc = win_srccol(n);
            tr_item(sc >= 0 ? w_in + sc : nullptr, DIN, ain(3) + l * D, 1024, (bf16*)(wl + W_IN), 64 * kb, 32 * nb, scr, lane); continue; } r -= I_IN;
        if (r < I_G) { const int kb = r / 96, nb = r % 96, n = 32 * nb + nl;
            tr_item(w_in + Z_GM + n, DIN, ain(3) + l * D, 1024, (bf16*)(wl + W_G), 64 * kb, 32 * nb, scr, lane); continue; } r -= I_G;
        if (r < I_Q2) { const int kb = r / 16, nb = r % 16, n = 32 * nb + nl;
            tr_item(ain(11) + (size_t)l * 256 * 512 + n, 512, ain(9) + l * 256, 256, (bf16*)(wl + W_Q2) + (size_t)1024 * 256, 64 * kb, 32 * nb, scr, lane); continue; } r -= I_Q2;
        if (r < I_PM) { const int kb = r / 32, nb = r % 32, n = 32 * nb + nl;
            tr_item(ain(17) + (size_t)l * 512 * 1024 + n, 1024, nullptr, 512, (bf16*)(wl + W_PM), 64 * kb, 32 * nb, scr, lane); continue; } r -= I_PM;
        if (r < I_PR) { const int kb = r / 32, nb = r % 32, n = 32 * nb + nl;
            tr_item(ain(19) + (size_t)l * 512 * 1024 + n, 1024, nullptr, 512, (bf16*)(wl + W_PR), 64 * kb, 32 * nb, scr, lane); continue; } r -= I_PR;
        if (r < I_OUT) { const int kb = r / 32, nb = r % 32, n = 32 * nb + nl;
            tr_item(ain(20) + (size_t)l * 1024 * 1024 + n, 1024, nullptr, 1024, (bf16*)(wl + W_OUT), 64 * kb, 32 * nb, scr, lane); continue; } r -= I_OUT;
        if (r < I_GU) { const int kb = r / 176, nb = r % 176, n = 32 * nb + nl, tile = n >> 8, rr = n & 255;
            const float* src = (rr < 128) ? ain(22) + (size_t)l * D * DFF + 128 * tile + rr : ain(23) + (size_t)l * D * DFF + 128 * tile + (rr - 128);
            tr_item(src, DFF, ain(21) + l * D, 1024, (bf16*)(wl + W_GU), 64 * kb, 32 * nb, scr, lane); continue; } r -= I_GU;
        { const int kb = r / 32, nb = r % 32, n = 32 * nb + nl;
            tr_item(ain(24) + (size_t)l * DFF * D + n, 1024, nullptr, 2816, (bf16*)(wl + W_DN), 64 * kb, 32 * nb, scr, lane); }
    }
    for (int it = gw; it < 2 * 512; it += NGW) {
        const int l = it >> 9, r = it & 511, k0 = (r >> 4) * 8, n = (r & 15) * 64 + lane, h = n >> 7, c = n & 127;
        const float* av = ain(10) + (size_t)l * 256 * 512 + (size_t)k0 * 512 + h * 64;
        const float* bv = ain(14) + (size_t)l * 8 * 64 * 128 + (size_t)h * 64 * 128 + c;
        float acc[8];
#pragma unroll
        for (int e = 0; e < 8; ++e) acc[e] = 0.f;
#pragma unroll 16
        for (int d = 0; d < 64; ++d) { const float x = bv[(size_t)d * 128];
#pragma unroll
            for (int e = 0; e < 8; ++e) acc[e] = fmaf(av[e * 512 + d], x, acc[e]); }
        const float* gq = ain(9) + l * 256 + k0;
        v4u o; o.x = pk2(acc[0] * 0.125f * gq[0], acc[1] * 0.125f * gq[1]); o.y = pk2(acc[2] * 0.125f * gq[2], acc[3] * 0.125f * gq[3]);
        o.z = pk2(acc[4] * 0.125f * gq[4], acc[5] * 0.125f * gq[5]); o.w = pk2(acc[6] * 0.125f * gq[6], acc[7] * 0.125f * gq[7]);
        *(GAS v4u*)((bf16*)(F.ws + WS_W + (size_t)l * W_LAYER + W_Q2) + (size_t)n * 256 + k0) = o;
    }
    for (int it = gw; it < 2 * 2048; it += NGW) {
        const int l = it >> 11, r = it & 2047, kk0 = (r >> 4) * 8, n = (r & 15) * 64 + lane, h = kk0 >> 7;
        const float* av = ain(15) + (size_t)l * 8 * 128 * 64 + (size_t)kk0 * 64;
        const float* bv = ain(18) + (size_t)l * 512 * 1024 + (size_t)(h * 64) * 1024 + n;
        float acc[8];
#pragma unroll
        for (int e = 0; e < 8; ++e) acc[e] = 0.f;
#pragma unroll 16
        for (int d = 0; d < 64; ++d) { const float x = bv[(size_t)d * 1024];
#pragma unroll
            for (int e = 0; e < 8; ++e) acc[e] = fmaf(av[e * 64 + d], x, acc[e]); }
        v4u o; o.x = pk2(acc[0], acc[1]); o.y = pk2(acc[2], acc[3]); o.z = pk2(acc[4], acc[5]); o.w = pk2(acc[6], acc[7]);
        *(GAS v4u*)((bf16*)(F.ws + WS_W + (size_t)l * W_LAYER + W_AV) + (size_t)n * 1024 + kk0) = o;
    }
    const int gt = F.vcu * NWAVES * 64 + F.wave * 64 + lane, NGT = F.G * NWAVES * 64;
    float* rot = (float*)(F.ws + WS_ROT);
    for (int e = gt; e < 2048 * 64; e += NGT) {
        const int t = e >> 6, i = e & 63;
        const float freq = (float)pow(10000.0, -(double)((float)i / 63.0f)), ang = (float)t * freq;
        rot[(size_t)t * 128 + i] = cosf(ang); rot[(size_t)t * 128 + 64 + i] = sinf(ang);
    }
    pg8::ssq_t ssq = ssq_arr(F, 0); bf16* XB = wsb(F, WS_XB);
#pragma unroll 4
    for (int m = gw; m < M; m += NGW) {
        const GAS f32x4* xr = (const GAS f32x4*)(ain(0) + (size_t)m * D) + lane;
        GAS unsigned long long* o8 = (GAS unsigned long long*)(XB + (size_t)m * D) + lane; float s = 0.f;
#pragma unroll
        for (int j = 0; j < 4; ++j) { const f32x4 v = __builtin_nontemporal_load(xr + 64 * j); s += (v.x * v.x + v.y * v.y) + (v.z * v.z + v.w * v.w);
            o8[64 * j] = (unsigned long long)pk2(v.x, v.y) | ((unsigned long long)pk2(v.z, v.w) << 32); }
        s = wave_sum(s); if (lane == 0) ssq[m] = __float2ll_rn(s * 1048576.f);
    }
}

__device__ __forceinline__ void p2_norms(Frame& F, int l) {
    const int gw = F.vcu * NWAVES + F.wave, NGW = F.G * NWAVES, lane = (opaque((int)threadIdx.x) & 63);
    const pg8::ssq_t ssq_ckv = ssq_arr(F, l * 6 + 3), sum_k = ssq_arr(F, l * 6 + 4), ssq_k = ssq_arr(F, l * 6 + 5);
    const bf16* CKV = wsb(F, WS_CKV); const bf16* KIDX = wsb(F, WS_KIDX); bf16* CKVN = wsb(F, WS_CKVN); bf16* KIDXN = wsb(F, WS_KIDXN);
    const int sub = lane & 15, rsel = lane >> 4;
    f32x4 gkv = *(const GAS f32x4*)(ain(12) + l * 64 + 4 * sub), gca = *(const GAS f32x4*)(ain(13) + l * 128 + 8 * sub), gcb = *(const GAS f32x4*)(ain(13) + l * 128 + 8 * sub + 4);
    for (int m4 = gw; m4 < M / 4; m4 += NGW) {
        const int m = 4 * m4 + rsel;
        const float mean = pg8::sget(sum_k, m) * (1.f / 64.f), var = pg8::sget(ssq_k, m) * (1.f / 64.f) - mean * mean, rk = rsqrtf(fmaxf(var, 0.f) + EPSN);
        const float rc = rsqrtf(pg8::sget(ssq_ckv, m) * (1.f / 128.f) + EPSN);
        const unsigned long long kq = *(const GAS unsigned long long*)(KIDX + (size_t)m * 64 + 4 * sub);
        const v4u cq = *(const GAS v4u*)(CKV + (size_t)m * 128 + 8 * sub);
        const unsigned k0 = (unsigned)kq, k1 = (unsigned)(kq >> 32);
        const unsigned o0 = pk2((__uint_as_float(k0 << 16) - mean) * rk * gkv.x, (__uint_as_float(k0 & 0xffff0000u) - mean) * rk * gkv.y);
        const unsigned o1 = pk2((__uint_as_float(k1 << 16) - mean) * rk * gkv.z, (__uint_as_float(k1 & 0xffff0000u) - mean) * rk * gkv.w);
        *(GAS unsigned long long*)(KIDXN + (size_t)m * 64 + 4 * sub) = (unsigned long long)o0 | ((unsigned long long)o1 << 32);
        v4u co;
        co.x = pk2(__uint_as_float(cq.x << 16) * rc * gca.x, __uint_as_float(cq.x & 0xffff0000u) * rc * gca.y);
        co.y = pk2(__uint_as_float(cq.y << 16) * rc * gca.z, __uint_as_float(cq.y & 0xffff0000u) * rc * gca.w);
        co.z = pk2(__uint_as_float(cq.z << 16) * rc * gcb.x, __uint_as_float(cq.z & 0xffff0000u) * rc * gcb.y);
        co.w = pk2(__uint_as_float(cq.w << 16) * rc * gcb.z, __uint_as_float(cq.w & 0xffff0000u) * rc * gcb.w);
        *(GAS v4u*)(CKVN + (size_t)m * 128 + 8 * sub) = co;
    }
}

typedef short s16x4 __attribute__((ext_vector_type(4)));
__device__ __forceinline__ unsigned offb(unsigned row, unsigned ch) { return 256u * row + 16u * (ch ^ (((row & 3u) << 2) | ((row >> 2) & 3u))); }
__device__ __forceinline__ bf16x8 frag_row(LAS unsigned char* img, int rowbase, int s, int lane) { return *(LAS bf16x8*)(img + offb(rowbase + (lane & 15), 4 * s + (lane >> 4))); }
template <bool PERM> __device__ __forceinline__ bf16x8 frag_tr(LAS unsigned char* img, int kbase, int c, int lane) {
    const unsigned g = lane >> 4, qq = (lane & 15) >> 2, pp = lane & 3;
    const unsigned r0 = kbase + (PERM ? 4 * g : 8 * g) + qq, r1 = r0 + (PERM ? 16 : 4), chn = 2 * c + (pp >> 1), bo = 8 * (pp & 1);
    const s16x4 lo = __builtin_amdgcn_ds_read_tr16_b64_v4i16((LAS s16x4*)(img + offb(r0, chn) + bo)), hi = __builtin_amdgcn_ds_read_tr16_b64_v4i16((LAS s16x4*)(img + offb(r1, chn) + bo));
    return (bf16x8){lo[0], lo[1], lo[2], lo[3], hi[0], hi[1], hi[2], hi[3]};
}
__device__ __forceinline__ unsigned offb2(unsigned row, unsigned ch) { return 256u * row + 16u * (ch ^ (((row & 3u) << 1) | ((row >> 3) & 1u) | ((((row >> 2) ^ (row >> 3)) & 1u) << 3))); }
__device__ __forceinline__ bf16x8 frag_row2(LAS unsigned char* img, int rowbase, int s, int lane) { return *(LAS bf16x8*)(img + offb2(rowbase + (lane & 15), 4 * s + (lane >> 4))); }
__device__ __forceinline__ bf16x8 frag_tr2(LAS unsigned char* img, int kbase, int c, int lane) {
    const unsigned g = lane >> 4, qq = (lane & 15) >> 2, pp = lane & 3;
    const unsigned r0 = kbase + 4 * g + qq, r1 = r0 + 16, chn = 2 * c + (pp >> 1), bo = 8 * (pp & 1);
    const s16x4 lo = __builtin_amdgcn_ds_read_tr16_b64_v4i16((LAS s16x4*)(img + offb2(r0, chn) + bo)), hi = __builtin_amdgcn_ds_read_tr16_b64_v4i16((LAS s16x4*)(img + offb2(r1, chn) + bo));
    return (bf16x8){lo[0], lo[1], lo[2], lo[3], hi[0], hi[1], hi[2], hi[3]};
}
typedef float f32x2_t __attribute__((ext_vector_type(2)));
typedef __bf16 bf16x2_t __attribute__((ext_vector_type(2)));
__device__ __forceinline__ unsigned pkbf(float a, float b) { const f32x2_t v = {a, b}; return __builtin_bit_cast(unsigned, __builtin_convertvector(v, bf16x2_t)); }
__device__ __forceinline__ bf16x8 pack_acc2(const f32x4& a, const f32x4& b) { v4u w; w.x = pkbf(a[0], a[1]); w.y = pkbf(a[2], a[3]); w.z = pkbf(b[0], b[1]); w.w = pkbf(b[2], b[3]); return __builtin_bit_cast(bf16x8, w); }
__device__ __forceinline__ v4u scale8(v4u x, float f) { v4u r;
    r.x = pkbf(__uint_as_float(x.x << 16) * f, __uint_as_float(x.x & 0xffff0000u) * f); r.y = pkbf(__uint_as_float(x.y << 16) * f, __uint_as_float(x.y & 0xffff0000u) * f);
    r.z = pkbf(__uint_as_float(x.z << 16) * f, __uint_as_float(x.z & 0xffff0000u) * f); r.w = pkbf(__uint_as_float(x.w << 16) * f, __uint_as_float(x.w & 0xffff0000u) * f); return r; }
#define MFMA16(a, b, c) __builtin_amdgcn_mfma_f32_16x16x32_bf16((a), (b), (c), 0, 0, 0)
#define SETTLE(x) do { __builtin_amdgcn_sched_barrier(0); asm volatile("s_nop 15\n\ts_nop 15"); __builtin_amdgcn_sched_barrier(0); } while (0)

__device__ __forceinline__ float row16_sum(float v) {
    v += __int_as_float(__builtin_amdgcn_update_dpp(0, __float_as_int(v), 0x121, 0xf, 0xf, false));
    v += __int_as_float(__builtin_amdgcn_update_dpp(0, __float_as_int(v), 0x122, 0xf, 0xf, false));
    v += __int_as_float(__builtin_amdgcn_update_dpp(0, __float_as_int(v), 0x124, 0xf, 0xf, false));
    v += __int_as_float(__builtin_amdgcn_update_dpp(0, __float_as_int(v), 0x128, 0xf, 0xf, false));
    return v;
}
__device__ __forceinline__ void retention_unit(Frame& F, int lyr, int b_, int h_) {
    const int b = opaque_s(b_), h = opaque_s(h_);
    const int lane = opaque((int)threadIdx.x) & 63, w = F.wave, tid = w * 64 + lane;
    LAS unsigned char* TQ = F.lds; LAS unsigned char* TK = TQ + 32768; LAS unsigned char* TV = TK + 32768; LAS unsigned char* TS = TV + 32768;
    const int g = lane >> 4, m16 = lane & 15;
    const float lg = log2f(1.f - exp2f(-5.f - (float)h));
    for (int i = tid; i < 2048; i += 512) *(LAS v4u*)(TS + 16 * i) = (v4u){0u, 0u, 0u, 0u};
    f32x4 Sacc[8];
#pragma unroll
    for (int ct = 0; ct < 8; ++ct) Sacc[ct] = (f32x4){0.f, 0.f, 0.f, 0.f};
    const bf16* RQ = wsb(F, WS_RQ); const bf16* RK = wsb(F, WS_RK); bf16* RV = wsb(F, WS_RV); const bf16* RG = wsb(F, WS_RG);
    const float* gn = ain(16) + lyr * 512 + h * 128;
    const int srow = tid >> 4, sch = tid & 15;
    const size_t gbase = ((size_t)b * S) * 512 + h * 128 + sch * 8;
    float rowdec[4];
#pragma unroll
    for (int r = 0; r < 4; ++r) rowdec[r] = exp2f((float)(16 * w + 4 * g + r + 1) * lg);
    const float colf = exp2f((float)(16 * w + m16 - 127) * lg), sdec = exp2f(128.f * lg);
    const int npair = (w >> 1) + 1;
    for (int c = 0; c < 16; ++c) {
#pragma unroll
        for (int i = 0; i < 4; ++i) { const int row = srow + 32 * i; const unsigned o = offb(row, sch); const size_t go = gbase + (size_t)(c * 128 + row) * 512;
            const v4u vq = *(const GAS v4u*)(RQ + go), vk = *(const GAS v4u*)(RK + go), vv = *(const GAS v4u*)(RV + go);
            *(LAS v4u*)(TQ + o) = vq; *(LAS v4u*)(TK + o) = scale8(vk, exp2f((float)(127 - row) * lg)); *(LAS v4u*)(TV + o) = vv; }
        WG_BAR_LDS();
        bf16x8 qf[4];
#pragma unroll
        for (int s = 0; s < 4; ++s) qf[s] = frag_row(TQ, 16 * w, s, lane);
        f32x4 O[8];
#pragma unroll
        for (int ct = 0; ct < 8; ++ct) { f32x4 a = (f32x4){0.f, 0.f, 0.f, 0.f};
#pragma unroll
            for (int s = 0; s < 4; ++s) a = MFMA16(qf[s], frag_tr<false>(TS, 32 * s, ct, lane), a);
            SETTLE(a);
#pragma unroll
            for (int r = 0; r < 4; ++r) a[r] *= rowdec[r];
            O[ct] = a; }
        for (int jp = 0; jp < npair; ++jp) {
            f32x4 c1[2];
#pragma unroll
            for (int hb = 0; hb < 2; ++hb) { f32x4 a = (f32x4){0.f, 0.f, 0.f, 0.f}; const int rb = 2 * jp + hb;
#pragma unroll
                for (int s = 0; s < 4; ++s) a = MFMA16(frag_row(TK, 16 * rb, s, lane), qf[s], a);
                SETTLE(a);
#pragma unroll
                for (int r = 0; r < 4; ++r) a[r] = (16 * rb + 4 * g + r <= 16 * w + m16) ? a[r] * colf : 0.f;
                c1[hb] = a; }
            const bf16x8 pf = pack_acc2(c1[0], c1[1]);
#pragma unroll
            for (int ct = 0; ct < 8; ++ct) O[ct] = MFMA16(pf, frag_tr<true>(TV, 32 * jp, ct, lane), O[ct]);
        }
#pragma unroll
        for (int ct = 0; ct < 8; ++ct) Sacc[ct] = Sacc[ct] * sdec;
#pragma unroll
        for (int s = 0; s < 4; ++s) { const bf16x8 kt = frag_tr<false>(TK, 32 * s, w, lane);
#pragma unroll
            for (int ct = 0; ct < 8; ++ct) Sacc[ct] = MFMA16(kt, frag_tr<false>(TV, 32 * s, ct, lane), Sacc[ct]); }
        float mean[4], rstd[4];
#pragma unroll
        for (int r = 0; r < 4; ++r) { float s1 = 0.f;
#pragma unroll
            for (int ct = 0; ct < 8; ++ct) s1 += O[ct][r];
            s1 = row16_sum(s1);
            mean[r] = s1 * (1.f / 128.f); float s2 = 0.f;
#pragma unroll
            for (int ct = 0; ct < 8; ++ct) { const float d = O[ct][r] - mean[r]; s2 += d * d; }
            s2 = row16_sum(s2);
            rstd[r] = rsqrtf(s2 * (1.f / 128.f) + EPSN); }
        { const int lq_ = opaque(lane), gq = lq_ >> 4, mq = lq_ & 15;
          LAS unsigned char* st = TQ + 4096 * w;
#pragma unroll
          for (int ct = 0; ct < 8; ++ct) { const float gv = gn[16 * ct + mq];
#pragma unroll
            for (int r = 0; r < 4; ++r) *(LAS bf16*)(st + (4 * gq + r) * 256 + (16 * ct + mq) * 2) = (bf16)f2bf((O[ct][r] - mean[r]) * rstd[r] * gv); }
          LDS_WAIT(); asm volatile("" ::: "memory");
#pragma unroll
          for (int i = 0; i < 4; ++i) { const int n = lq_ + 64 * i, row = n >> 4, ch = n & 15;
            const v4u xv = *(LAS v4u*)(st + row * 256 + ch * 16);
            const size_t o = ((size_t)b * S + c * 128 + 16 * w + row) * 512 + h * 128 + ch * 8;
            const v4u gt = *(const GAS v4u*)(RG + o); v4u ov;
            { const float g0 = __uint_as_float(gt.x << 16), g1 = __uint_as_float(gt.x & 0xffff0000u); ov.x = pkbf(__uint_as_float(xv.x << 16) * g0 / (1.f + __expf(-g0)), __uint_as_float(xv.x & 0xffff0000u) * g1 / (1.f + __expf(-g1))); }
            { const float g0 = __uint_as_float(gt.y << 16), g1 = __uint_as_float(gt.y & 0xffff0000u); ov.y = pkbf(__uint_as_float(xv.y << 16) * g0 / (1.f + __expf(-g0)), __uint_as_float(xv.y & 0xffff0000u) * g1 / (1.f + __expf(-g1))); }
            { const float g0 = __uint_as_float(gt.z << 16), g1 = __uint_as_float(gt.z & 0xffff0000u); ov.z = pkbf(__uint_as_float(xv.z << 16) * g0 / (1.f + __expf(-g0)), __uint_as_float(xv.z & 0xffff0000u) * g1 / (1.f + __expf(-g1))); }
            { const float g0 = __uint_as_float(gt.w << 16), g1 = __uint_as_float(gt.w & 0xffff0000u); ov.w = pkbf(__uint_as_float(xv.w << 16) * g0 / (1.f + __expf(-g0)), __uint_as_float(xv.w & 0xffff0000u) * g1 / (1.f + __expf(-g1))); }
            *(GAS v4u*)(RV + o) = ov; }
        }
        WG_BAR_LDS();
        const int lo_ = opaque(lane), go = lo_ >> 4, mo = lo_ & 15;
#pragma unroll
        for (int ct = 0; ct < 8; ++ct)
#pragma unroll
            for (int r = 0; r < 4; ++r) { const unsigned row = 16 * w + 4 * go + r, col = 16 * ct + mo;
                *(LAS bf16*)(TS + offb(row, col >> 3) + 2 * (col & 7)) = (bf16)f2bf(Sacc[ct][r]); }
    }
    WG_BAR_LDS();
}
__device__ __forceinline__ float log_sigmoid(float x) { return fminf(x, 0.f) - log1pf(__expf(-fabsf(x))); }
__device__ __forceinline__ void mlstm_unit(Frame& F, int lyr, int b_, int h_) {
    const int b = opaque_s(b_), h = opaque_s(h_);
    const int lane = opaque((int)threadIdx.x) & 63, w = F.wave, tid = w * 64 + lane;
    LAS unsigned char* TQK = F.lds; LAS unsigned char* TV = TQK + 32768; LAS unsigned char* TS = TV + 32768; LAS unsigned char* TN = TS + 16384;
    LAS float* GB = (LAS float*)(TN + 16384);
    LAS float* G_bc = GB, *G_u = GB + 128, *G_pm = GB + 256, *G_s0 = GB + 384, *G_sc = GB + 640;
    const int g = lane >> 4, m16 = lane & 15;
    for (int i = tid; i < 2048; i += 512) *(LAS v4u*)(TS + 16 * i) = (v4u){0u, 0u, 0u, 0u};
    f32x4 Cacc[4], nacc = (f32x4){0.f, 0.f, 0.f, 0.f};
#pragma unroll
    for (int j = 0; j < 4; ++j) Cacc[j] = (f32x4){0.f, 0.f, 0.f, 0.f};
    const bf16* MQK = wsb(F, WS_MQK); bf16* MV = wsb(F, WS_MV); const bf16* MO = wsb(F, WS_MO); const float* MIF = (const float*)(F.ws + WS_MIF);
    const float* gn = ain(8) + lyr * 512 + h * 128;
    const int srow = tid >> 4, sch = tid & 15;
    const int qkcol = (sch < 8) ? (h * 64 + 8 * sch) : (256 + h * 64 + 8 * (sch - 8));
    float cw[4][8];
    { const float* cv = ain(5) + (size_t)lyr * 4 * 512 + qkcol;
#pragma unroll
      for (int j = 0; j < 4; ++j)
#pragma unroll
        for (int e = 0; e < 8; ++e) cw[j][e] = cv[j * 512 + e]; }
    const float qsc = (sch < 8) ? 0.125f : 1.f;
    const bf16x8 ones = (bf16x8){0x3f80, 0x3f80, 0x3f80, 0x3f80, 0x3f80, 0x3f80, 0x3f80, 0x3f80};
    float m_st = 0.f;
    const int npair = (w >> 1) + 1, kt = w & 3, vt0 = 4 * (w >> 2);
    for (int c = 0; c < 16; ++c) {
#pragma unroll 1
        for (int i = 0; i < 4; ++i) { const int row = srow + 32 * i, t = c * 128 + row; const size_t rbase = ((size_t)b * S + t) * 512;
            float a[8];
#pragma unroll
            for (int e = 0; e < 8; ++e) a[e] = 0.f;
#pragma unroll
            for (int j = 0; j < 4; ++j) { const int tt = t - 3 + j;
                if (tt >= 0) { const v4u x = *(const GAS v4u*)(MQK + (rbase - (size_t)(3 - j) * 512) + qkcol);
                    a[0] = fmaf(cw[j][0], __uint_as_float(x.x << 16), a[0]); a[1] = fmaf(cw[j][1], __uint_as_float(x.x & 0xffff0000u), a[1]);
                    a[2] = fmaf(cw[j][2], __uint_as_float(x.y << 16), a[2]); a[3] = fmaf(cw[j][3], __uint_as_float(x.y & 0xffff0000u), a[3]);
                    a[4] = fmaf(cw[j][4], __uint_as_float(x.z << 16), a[4]); a[5] = fmaf(cw[j][5], __uint_as_float(x.z & 0xffff0000u), a[5]);
                    a[6] = fmaf(cw[j][6], __uint_as_float(x.w << 16), a[6]); a[7] = fmaf(cw[j][7], __uint_as_float(x.w & 0xffff0000u), a[7]); } }
#pragma unroll
            for (int e = 0; e < 8; ++e) a[e] = a[e] / (1.f + __expf(-a[e])) * qsc;
            v4u o; o.x = pkbf(a[0], a[1]); o.y = pkbf(a[2], a[3]); o.z = pkbf(a[4], a[5]); o.w = pkbf(a[6], a[7]);
            *(LAS v4u*)(TQK + offb(row, sch)) = o;
            *(LAS v4u*)(TV + offb(row, sch)) = *(const GAS v4u*)(MV + rbase + h * 128 + sch * 8); }
        if (w == 0) {
            const size_t r0 = (size_t)b * S + c * 128;
            float x0 = log_sigmoid(MIF[(r0 + lane) * 8 + 4 + h]), x1 = log_sigmoid(MIF[(r0 + lane + 64) * 8 + 4 + h]);
            const float li0 = MIF[(r0 + lane) * 8 + h], li1 = MIF[(r0 + lane + 64) * 8 + h];
#pragma unroll 1
            for (int d = 1; d < 128; d <<= 1) { G_s0[lane] = x0; G_s0[lane + 64] = x1; LDS_WAIT(); asm volatile("" ::: "memory");
                const float y0 = (lane >= d) ? G_s0[lane - d] : 0.f, y1 = G_s0[lane + 64 - d]; LDS_WAIT(); asm volatile("" ::: "memory"); x0 += y0; x1 += y1; }
            G_bc[lane] = x0; G_bc[lane + 64] = x1;
            float u0 = li0 - x0, u1 = li1 - x1; G_u[lane] = u0; G_u[lane + 64] = u1;
            const float blast = __int_as_float(__builtin_amdgcn_readlane(__float_as_int(x1), 63));
#pragma unroll 1
            for (int d = 1; d < 128; d <<= 1) { G_s0[lane] = u0; G_s0[lane + 64] = u1; LDS_WAIT(); asm volatile("" ::: "memory");
                const float y0 = (lane >= d) ? G_s0[lane - d] : -INFINITY, y1 = G_s0[lane + 64 - d]; LDS_WAIT(); asm volatile("" ::: "memory"); u0 = fmaxf(u0, y0); u1 = fmaxf(u1, y1); }
            u0 = fmaxf(u0, m_st); u1 = fmaxf(u1, m_st);
            G_pm[lane] = u0; G_pm[lane + 64] = u1;
            const float pml = __int_as_float(__builtin_amdgcn_readlane(__float_as_int(u1), 63));
            if (lane == 0) { G_sc[0] = m_st; G_sc[1] = pml; }
            m_st = blast + pml;
        }
        WG_BAR_LDS();
        const int lc = opaque(lane), gq = lc >> 4, mq = lc & 15;
        const float mst_c = G_sc[0], pm_last = G_sc[1];
        bf16x8 qf[2];
#pragma unroll
        for (int s = 0; s < 2; ++s) qf[s] = frag_row(TQK, 16 * w, s, lc);
        f32x4 O[9];
        const f32x4 pmr = *(LAS f32x4*)(G_pm + 16 * w + 4 * gq), bcr = *(LAS f32x4*)(G_bc + 16 * w + 4 * gq);
        float wint[4];
#pragma unroll
        for (int r = 0; r < 4; ++r) wint[r] = __expf(mst_c - pmr[r]);
#pragma unroll
        for (int ct = 0; ct < 9; ++ct) { f32x4 a = (f32x4){0.f, 0.f, 0.f, 0.f};
#pragma unroll
            for (int s = 0; s < 2; ++s) a = MFMA16(qf[s], (ct < 8) ? frag_tr<false>(TS, 32 * s, ct, lc) : frag_tr<false>(TN, 32 * s, 0, lc), a);
#pragma unroll
            for (int r = 0; r < 4; ++r) a[r] *= wint[r];
            O[ct] = a; }
        const float pml_ = G_pm[16 * w + mq];
        for (int jp = 0; jp < npair; ++jp) {
            f32x4 c1[2];
#pragma unroll
            for (int hb = 0; hb < 2; ++hb) { f32x4 a = (f32x4){0.f, 0.f, 0.f, 0.f}; const int rb = 2 * jp + hb;
#pragma unroll
                for (int s = 0; s < 2; ++s) a = MFMA16(frag_row(TQK, 16 * rb, 2 + s, lc), qf[s], a);
                const f32x4 ur = *(LAS f32x4*)(G_u + 16 * rb + 4 * gq);
#pragma unroll
                for (int r = 0; r < 4; ++r) a[r] = (16 * rb + 4 * gq + r <= 16 * w + mq) ? a[r] * __expf(ur[r] - pml_) : 0.f;
                c1[hb] = a; }
            const bf16x8 pf = pack_acc2(c1[0], c1[1]);
#pragma unroll
            for (int ct = 0; ct < 8; ++ct) O[ct] = MFMA16(pf, frag_tr<true>(TV, 32 * jp, ct, lc), O[ct]);
            O[8] = MFMA16(pf, ones, O[8]);
        }
        { const float decay = __expf(mst_c - pm_last);
#pragma unroll
          for (int j = 0; j < 4; ++j) Cacc[j] = Cacc[j] * decay;
          nacc = nacc * decay;
#pragma unroll
          for (int s = 0; s < 4; ++s) { const bf16x8 kraw = frag_tr<false>(TQK, 32 * s, 4 + kt, lc);
            const f32x4 ua = *(LAS f32x4*)(G_u + 32 * s + 8 * gq), ub = *(LAS f32x4*)(G_u + 32 * s + 8 * gq + 4);
            const v4u kr = __builtin_bit_cast(v4u, kraw); v4u ks;
            ks.x = pkbf(__uint_as_float(kr.x << 16) * __expf(ua[0] - pm_last), __uint_as_float(kr.x & 0xffff0000u) * __expf(ua[1] - pm_last));
            ks.y = pkbf(__uint_as_float(kr.y << 16) * __expf(ua[2] - pm_last), __uint_as_float(kr.y & 0xffff0000u) * __expf(ua[3] - pm_last));
            ks.z = pkbf(__uint_as_float(kr.z << 16) * __expf(ub[0] - pm_last), __uint_as_float(kr.z & 0xffff0000u) * __expf(ub[1] - pm_last));
            ks.w = pkbf(__uint_as_float(kr.w << 16) * __expf(ub[2] - pm_last), __uint_as_float(kr.w & 0xffff0000u) * __expf(ub[3] - pm_last));
            const bf16x8 kw = __builtin_bit_cast(bf16x8, ks);
#pragma unroll
            for (int j = 0; j < 4; ++j) Cacc[j] = MFMA16(kw, frag_tr<false>(TV, 32 * s, vt0 + j, lc), Cacc[j]);
            nacc = MFMA16(kw, ones, nacc); } }
        float mean[4], rstd[4];
#pragma unroll
        for (int r = 0; r < 4; ++r) { const float inv = 1.f / fmaxf(fabsf(O[8][r]), __expf(-(bcr[r] + pmr[r]))); float s1 = 0.f;
#pragma unroll
            for (int ct = 0; ct < 8; ++ct) { O[ct][r] *= inv; s1 += O[ct][r]; }
            s1 = row16_sum(s1); mean[r] = s1 * (1.f / 128.f); float s2 = 0.f;
#pragma unroll
            for (int ct = 0; ct < 8; ++ct) { const float d = O[ct][r] - mean[r]; s2 += d * d; }
            s2 = row16_sum(s2); rstd[r] = rsqrtf(s2 * (1.f / 128.f) + EPSN); }
        WG_BAR_LDS();
#pragma unroll
        for (int j = 0; j < 4; ++j)
#pragma unroll
            for (int r = 0; r < 4; ++r) { const unsigned row = 16 * kt + 4 * gq + r, col = 16 * (vt0 + j) + mq;
                *(LAS bf16*)(TS + offb(row, col >> 3) + 2 * (col & 7)) = (bf16)f2bf(Cacc[j][r]); }
        if (w < 4) {
#pragma unroll
            for (int r = 0; r < 4; ++r) { const unsigned row = 16 * kt + 4 * gq + r;
                *(LAS bf16*)(TN + offb(row, mq >> 3) + 2 * (mq & 7)) = (bf16)f2bf(nacc[r]); } }
        { LAS unsigned char* st = TQK + 4096 * w;
#pragma unroll
          for (int ct = 0; ct < 8; ++ct) { const float gv = gn[16 * ct + mq];
#pragma unroll
            for (int r = 0; r < 4; ++r) *(LAS bf16*)(st + (4 * gq + r) * 256 + (16 * ct + mq) * 2) = (bf16)f2bf((O[ct][r] - mean[r]) * rstd[r] * gv); }
          LDS_WAIT(); asm volatile("" ::: "memory");
#pragma unroll 1
          for (int i = 0; i < 4; ++i) { const int n = lc + 64 * i, row = n >> 4, ch = n & 15;
            const v4u xv = *(LAS v4u*)(st + row * 256 + ch * 16);
            const size_t o = ((size_t)b * S + c * 128 + 16 * w + row) * 512 + h * 128 + ch * 8;
            const v4u gt = *(const GAS v4u*)(MO + o); v4u ov;
            { const float g0 = __uint_as_float(gt.x << 16), g1 = __uint_as_float(gt.x & 0xffff0000u); ov.x = pkbf(__uint_as_float(xv.x << 16) / (1.f + __expf(-g0)), __uint_as_float(xv.x & 0xffff0000u) / (1.f + __expf(-g1))); }
            { const float g0 = __uint_as_float(gt.y << 16), g1 = __uint_as_float(gt.y & 0xffff0000u); ov.y = pkbf(__uint_as_float(xv.y << 16) / (1.f + __expf(-g0)), __uint_as_float(xv.y & 0xffff0000u) / (1.f + __expf(-g1))); }
            { const float g0 = __uint_as_float(gt.z << 16), g1 = __uint_as_float(gt.z & 0xffff0000u); ov.z = pkbf(__uint_as_float(xv.z << 16) / (1.f + __expf(-g0)), __uint_as_float(xv.z & 0xffff0000u) / (1.f + __expf(-g1))); }
            { const float g0 = __uint_as_float(gt.w << 16), g1 = __uint_as_float(gt.w & 0xffff0000u); ov.w = pkbf(__uint_as_float(xv.w << 16) / (1.f + __expf(-g0)), __uint_as_float(xv.w & 0xffff0000u) / (1.f + __expf(-g1))); }
            *(GAS v4u*)(MV + o) = ov; }
        }
        WG_BAR_LDS();
    }
    WG_BAR_LDS();
}
__device__ __forceinline__ int t5_bucket(int d) {
    if (d < 16) return d;
    int b = 16;
    b += (d >= 19); b += (d >= 21); b += (d >= 24); b += (d >= 27); b += (d >= 31); b += (d >= 35); b += (d >= 40); b += (d >= 46);
    b += (d >= 52); b += (d >= 59); b += (d >= 67); b += (d >= 77); b += (d >= 87); b += (d >= 99); b += (d >= 113);
    return b;
}
__device__ __forceinline__ unsigned wave_incl_scan_u32(unsigned x) {
    int v = (int)x;
    v += __builtin_amdgcn_update_dpp(0, v, 0x111, 0xf, 0xf, true);
    v += __builtin_amdgcn_update_dpp(0, v, 0x112, 0xf, 0xf, true);
    v += __builtin_amdgcn_update_dpp(0, v, 0x114, 0xf, 0xf, true);
    v += __builtin_amdgcn_update_dpp(0, v, 0x118, 0xf, 0xf, true);
    v += __builtin_amdgcn_update_dpp(0, v, 0x142, 0xa, 0xf, false);
    v += __builtin_amdgcn_update_dpp(0, v, 0x143, 0xc, 0xf, false);
    return (unsigned)v;
}
__device__ __forceinline__ float relu0(float x) { const int b = __builtin_bit_cast(int, x); return __builtin_bit_cast(float, b > 0 ? b : 0); }
__device__ __forceinline__ unsigned fkey(float f) { const unsigned u = __float_as_uint(f); return u ^ ((unsigned)((int)u >> 31) | 0x80000000u); }
__device__ __forceinline__ void dsa_phase(Frame& F, int l) {
    const int lane = (opaque((int)threadIdx.x) & 63), w = F.wave;
    LAS float* s_q = (LAS float*)(F.lds + w * 13312);
    LAS unsigned* s_qb = (LAS unsigned*)s_q;
    LAS float* s_p = s_q + 1024;
    LAS int* s_sel = (LAS int*)(s_p + 2048);
    const bf16* QIDX = wsb(F, WS_QIDX); const bf16* KIDXN = wsb(F, WS_KIDXN); bf16* QLAT = wsb(F, WS_QLAT); const bf16* CKVN = wsb(F, WS_CKVN);
    const float* WIDX = (const float*)(F.ws + WS_WIDX); const float* rel_bias = ain(1);
    LAS unsigned char* img = (LAS unsigned char*)s_p; LAS float* s_red = s_q + 512; LAS unsigned char* s_out = (LAS unsigned char*)s_p;
    const int g4 = lane >> 4, m16 = lane & 15, hd = m16 & 7;
    LAS float* s_bd = (LAS float*)(F.lds + LDSCTL_OFF + 1024);
    for (int i = lane; i < 1024; i += 64) s_bd[i] = rel_bias[t5_bucket(i >> 3) * 8 + (i & 7)] * 1.4426950408889634f;
    float bmax = 0.f;
    for (int k = 0; k < 32; ++k) bmax = fmaxf(bmax, fabsf(rel_bias[k * 8 + hd]));
    float gmax = fmaxf(fabsf(ain(13)[l * 128 + lane]), fabsf(ain(13)[l * 128 + 64 + lane]));
    s_red[lane] = gmax; LDS_WAIT(); asm volatile("" ::: "memory");
    for (int k = 0; k < 64; ++k) gmax = fmaxf(gmax, s_red[k]);
    const float BKV = 1.01f * 11.313708498984761f * gmax;
    LDS_WAIT(); asm volatile("" ::: "memory");
    const bf16x8 ones = (bf16x8){0x3f80, 0x3f80, 0x3f80, 0x3f80, 0x3f80, 0x3f80, 0x3f80, 0x3f80};
    gu32* ctr = (gu32*)(F.ws + WS_CTL) + 16 + l;
    LAS unsigned* hist = (LAS unsigned*)s_q;
    LAS int* s_selB = (LAS int*)(s_q + 256);
    LAS unsigned* s_keyB = (LAS unsigned*)img;
    LAS unsigned char* kring = F.lds + 8 * 13312;
    LAS unsigned* s_tk = (LAS unsigned*)(F.lds + LDSCTL_OFF + 5120);
    for (;;) {
        WG_BAR_LDS();
        if (opaque((int)threadIdx.x) == 0) *s_tk = __hip_atomic_fetch_add(ctr, 1u, RLX_AGENT);
        WG_BAR_LDS();
        const unsigned tk = (unsigned)__builtin_amdgcn_readfirstlane((int)*s_tk);
        if (tk >= (unsigned)(M / 16)) break;
        const int tkk = M / 16 - 1 - (int)tk, bb = tkk & 15, P = tkk >> 4, tA = 16 * P + 2 * w + 1, tB = tA - 1, rowA = bb * 2048 + tA, rowB = rowA - 1;
        bf16x8 qA[2]; float wr[4];
        { const int rq = (m16 < 8) ? rowA : rowB;
#pragma unroll
          for (int s2 = 0; s2 < 2; ++s2) qA[s2] = __builtin_bit_cast(bf16x8, *(const GAS v4u*)(QIDX + (size_t)rq * 512 + hd * 64 + 32 * s2 + 8 * g4));
          const int rw = (g4 < 2) ? rowA : rowB;
#pragma unroll
          for (int r = 0; r < 4; ++r) wr[r] = WIDX[(size_t)rw * 8 + 4 * (g4 & 1) + r]; }
        LAS float* scr = s_q + 256;
        unsigned key[32];
        const int nj = ((16 * P + 15) >> 6) + 1;
#define DSA_KDMA(jj) __builtin_amdgcn_global_load_lds((const unsigned*)((const char*)(KIDXN + ((size_t)bb * S + 64 * (jj)) * 64) + 128 * (16 * (w >> 1) + m16) + 64 * (w & 1) + 16 * g4), \
                                                      (LAS unsigned*)(kring + ((jj) % 3) * 8192 + w * 1024), 16, 0, 0)
        DSA_KDMA(0); if (nj > 1) DSA_KDMA(1);
#pragma unroll
        for (int j = 0; j < 32; ++j) {
            key[j] = 0u;
            if (j < nj) {
                if (j + 1 < nj) asm volatile("s_waitcnt vmcnt(1)" ::: "memory"); else asm volatile("s_waitcnt vmcnt(0)" ::: "memory");
                __builtin_amdgcn_s_barrier();
                asm volatile("" ::: "memory");
                if (j + 2 < nj) DSA_KDMA(j + 2);
                v4u kfr[4][2];
#pragma unroll
                for (int bq = 0; bq < 4; ++bq)
#pragma unroll
                    for (int s2 = 0; s2 < 2; ++s2) kfr[bq][s2] = *(const LAS v4u*)(kring + (j % 3) * 8192 + (bq * 2 + s2) * 1024 + lane * 16);
                float part[4]; f32x4 ab[4];
#pragma unroll
                for (int bq = 0; bq < 4; ++bq) ab[bq] = MFMA16(qA[0], __builtin_bit_cast(bf16x8, kfr[bq][0]), ((f32x4){0.f, 0.f, 0.f, 0.f}));
#pragma unroll
                for (int bq = 0; bq < 4; ++bq) ab[bq] = MFMA16(qA[1], __builtin_bit_cast(bf16x8, kfr[bq][1]), ab[bq]);
#pragma unroll
                for (int bq = 0; bq < 4; ++bq) part[bq] = (wr[0] * relu0(ab[bq][0]) + wr[1] * relu0(ab[bq][1])) + (wr[2] * relu0(ab[bq][2]) + wr[3] * relu0(ab[bq][3]));
#pragma unroll
                for (int bq = 0; bq < 4; ++bq) { const auto s = __builtin_amdgcn_permlane16_swap(__float_as_uint(part[bq]), __float_as_uint(part[bq]), false, false);
                    part[bq] = __uint_as_float(s[0]) + __uint_as_float(s[1]); }
                const auto r02 = __builtin_amdgcn_permlane32_swap(__float_as_uint(part[0]), __float_as_uint(part[2]), false, false);
                const auto r13 = __builtin_amdgcn_permlane32_swap(__float_as_uint(part[1]), __float_as_uint(part[3]), false, false);
                const float scA = __uint_as_float((g4 & 1) ? r13[0] : r02[0]), scB = __uint_as_float((g4 & 1) ? r13[1] : r02[1]);
                if (lane + 64 * j <= tA) key[j] = fkey(scA);
                s_keyB[64 * j + lane] = (lane + 64 * j <= tB) ? fkey(scB) : 0u;
            }
        }
        int nselA = 0, nselB = 0;
#define DSA_SELECT(NJ) { \
            if (qi) { \
                asm volatile("s_waitcnt lgkmcnt(0)" ::: "memory"); \
                _Pragma("unroll") \
                for (int j = 0; j < NJ; ++j) key[j] = (j < nj) ? s_keyB[64 * j + lane] : 0u; } \
            unsigned T = 0u; int need = 0; bool exact = false; \
            const bool all = (tq + 1 <= 256); \
            if (!all) {                                            \
                unsigned prefix = 0u; int r = 256;                 \
                _Pragma("unroll 1") \
                for (int pass = 0; pass < 4; ++pass) { \
                    const int sh = 24 - 8 * pass; \
                    *(LAS v4u*)(hist + 4 * lane) = (v4u){0u, 0u, 0u, 0u}; \
                    _Pragma("unroll") \
                    for (int j = 0; j < NJ; ++j) { const unsigned k = key[j]; \
                        if (pass == 0 || (k >> (sh + 8)) == prefix) (void)__hip_atomic_fetch_add(hist + ((k >> sh) & 255u), 1u, __ATOMIC_RELAXED, __HIP_MEMORY_SCOPE_WORKGROUP); } \
                    const v4u h = *(const LAS v4u*)(hist + 4 * lane);                \
                    const unsigned inc = wave_incl_scan_u32(h.x + h.y + h.z + h.w); \
                    const unsigned U = (unsigned)__builtin_amdgcn_readlane((int)inc, 63) - inc;     \
                    const unsigned s3 = U + h.w, s2 = s3 + h.z, s1 = s2 + h.y, s0 = s1 + h.x;       \
                    const unsigned ur = (unsigned)r; \
                    const int Lh = 63 - __clzll(__ballot(s0 >= ur));                   \
                    const int isel = (s3 >= ur) ? 3 : ((s2 >= ur) ? 2 : ((s1 >= ur) ? 1 : 0)); \
                    const unsigned hsel = isel == 3 ? h.w : (isel == 2 ? h.z : (isel == 1 ? h.y : h.x)), ssel = isel == 3 ? s3 : (isel == 2 ? s2 : (isel == 1 ? s1 : s0)); \
                    const unsigned dL = 4u * (unsigned)Lh + (unsigned)__builtin_amdgcn_readlane(isel, Lh); \
                    const unsigned hL = (unsigned)__builtin_amdgcn_readlane((int)hsel, Lh), sL = (unsigned)__builtin_amdgcn_readlane((int)ssel, Lh); \
                    prefix = (prefix << 8) | dL; \
                    r -= (int)(sL - hL);                                               \
                    T = prefix << sh; \
                    if ((int)hL == r) { exact = true; break; }                         \
                } \
                if (!exact) need = r;                                                  \
            } \
            int running = 0, eqrun = 0; \
            const unsigned long long lt = (1ull << lane) - 1ull; \
            if (all) {                                             \
                _Pragma("unroll") \
                for (int j = 0; j < NJ; ++j) { \
                    const int s = lane + 64 * j; \
                    const bool take = (s <= tq); \
                    const unsigned long long mt = __ballot(take); \
                    const int pos = running + __popcll(mt & lt); \
                    if (take) selp[pos] = s; \
                    running += __popcll(mt); \
                } \
            } else if (exact) {                                    \
                _Pragma("unroll") \
                for (int j = 0; j < NJ; ++j) { \
                    const bool take = key[j] >= T; \
                    const unsigned long long mt = __ballot(take); \
                    const int pos = running + __popcll(mt & lt); \
                    if (take) selp[pos] = lane + 64 * j; \
                    running += __popcll(mt); \
                } \
            } else \
            _Pragma("unroll") \
            for (int j = 0; j < NJ; ++j) { \
                const int s = lane + 64 * j; \
                const bool valid = (s <= tq); \
                const bool is_eq = valid && !all && key[j] == T; \
                const unsigned long long meq = __ballot(is_eq); \
                const int rank_eq = eqrun + __popcll(meq & lt); \
                const bool take = valid && (all || (exact ? key[j] >= T : (key[j] > T || (is_eq && rank_eq < need)))); \
                const unsigned long long mt = __ballot(take); \
                const int pos = running + __popcll(mt & lt); \
                if (take) selp[pos] = s; \
                running += __popcll(mt); eqrun += __popcll(meq); \
            } \
            if (qi) nselB = running; else nselA = running; }
#pragma unroll 1
        for (int qi = 0; qi < 2; ++qi) {
            const int tq = qi ? tB : tA; LAS int* selp = qi ? s_selB : s_sel;
            if (nj <= 16) { if (nj <= 8) { if (nj <= 4) DSA_SELECT(4) else DSA_SELECT(8) } else { if (nj <= 12) DSA_SELECT(12) else DSA_SELECT(16) } }
            else { if (nj <= 24) { if (nj <= 20) DSA_SELECT(20) else DSA_SELECT(24) } else { if (nj <= 28) DSA_SELECT(28) else DSA_SELECT(32) } }
        }
#undef DSA_SELECT
#pragma unroll 1
        for (int qi = 0; qi < 2; ++qi) {
            const int tq = qi ? tB : tA, rowq = qi ? rowB : rowA, nselq = qi ? nselB : nselA; LAS int* selp = qi ? s_selB : s_sel;
        LDS_WAIT(); asm volatile("" ::: "memory");
            const int grow = lane >> 4, gch = lane & 15;
            const char* ckb = (const char*)(CKVN + (size_t)bb * S * 128);
            v4u nx[8];
#define ATT_GATHER(JP) { int kk[8]; _Pragma("unroll") for (int i = 0; i < 8; ++i) kk[i] = selp[(32 * (JP) + 4 * i + grow) & 255]; \
                if (32 * ((JP) + 1) > nselq) { _Pragma("unroll") for (int i = 0; i < 8; ++i) kk[i] = (32 * (JP) + 4 * i + grow < nselq) ? kk[i] : 0; }     \
                _Pragma("unroll") for (int i = 0; i < 8; ++i) nx[i] = *(const GAS v4u*)(ckb + ((unsigned)kk[i] * 256u + (unsigned)gch * 16u)); }
            ATT_GATHER(0)
            bf16x8 qB[4]; float ss = 0.f;
#pragma unroll
            for (int s4 = 0; s4 < 4; ++s4) { v4u q4 = (v4u){0u, 0u, 0u, 0u};
                if (m16 < 8) q4 = *(const GAS v4u*)(QLAT + (size_t)rowq * 1024 + m16 * 128 + 32 * s4 + 8 * g4);
                qB[s4] = __builtin_bit_cast(bf16x8, q4);
                const float a0 = __uint_as_float(q4.x << 16), a1 = __uint_as_float(q4.x & 0xffff0000u), a2 = __uint_as_float(q4.y << 16), a3 = __uint_as_float(q4.y & 0xffff0000u),
                            a4 = __uint_as_float(q4.z << 16), a5 = __uint_as_float(q4.z & 0xffff0000u), a6 = __uint_as_float(q4.w << 16), a7 = __uint_as_float(q4.w & 0xffff0000u);
                ss += (a0 * a0 + a1 * a1) + (a2 * a2 + a3 * a3) + (a4 * a4 + a5 * a5) + (a6 * a6 + a7 * a7); }
            s_red[lane] = ss; LDS_WAIT(); asm volatile("" ::: "memory");
            const float mh = sqrtf(s_red[m16] + s_red[m16 + 16] + s_red[m16 + 32] + s_red[m16 + 48]) * BKV + bmax;
            LDS_WAIT(); asm volatile("" ::: "memory");
            f32x4 O[9];
#pragma unroll
            for (int ct = 0; ct < 9; ++ct) O[ct] = (f32x4){0.f, 0.f, 0.f, 0.f};
            const int npr = (nselq + 31) >> 5;
#pragma unroll 1
            for (int jp = 0; jp < npr; ++jp) {
#pragma unroll
                for (int i = 0; i < 8; ++i) *(LAS v4u*)(img + offb2(4 * i + grow, gch)) = nx[i];
                if (jp + 1 < npr) ATT_GATHER(jp + 1)
                f32x4 pr[2];
#pragma unroll
                for (int hb = 0; hb < 2; ++hb) {
                    f32x4 a = (f32x4){-mh, -mh, -mh, -mh};
#pragma unroll
                    for (int s4 = 0; s4 < 4; ++s4) a = MFMA16(frag_row2(img, 16 * hb, s4, lane), qB[s4], a);
                    pr[hb] = a; }
#pragma unroll
                for (int hb = 0; hb < 2; ++hb) { const int sl0 = 32 * jp + 16 * hb + 4 * g4;
                    const v4u kr4 = *(const LAS v4u*)(selp + sl0);
#pragma unroll
                    for (int r = 0; r < 4; ++r) { const int dd = min(max(tq - (int)kr4[r], 0), 127);
                        pr[hb][r] = __builtin_amdgcn_exp2f(fmaf(pr[hb][r], 1.4426950408889634f, s_bd[dd * 8 + hd])); }
                    if (32 * (jp + 1) > nselq) {
#pragma unroll
                        for (int r = 0; r < 4; ++r) pr[hb][r] = (sl0 + r < nselq) ? pr[hb][r] : 0.f; } }
                const bf16x8 pf = pack_acc2(pr[0], pr[1]);
                asm volatile("s_waitcnt lgkmcnt(0)" ::: "memory");
                bf16x8 vf[8];
#pragma unroll
                for (int ct = 0; ct < 8; ++ct) vf[ct] = frag_tr2(img, 0, ct, lane);
                O[8] = MFMA16(pf, ones, O[8]);
#pragma unroll
                for (int ct = 0; ct < 8; ++ct) O[ct] = MFMA16(pf, vf[ct], O[ct]);
                asm volatile("s_waitcnt lgkmcnt(0)" ::: "memory");
            }
            if (g4 < 2) {
#pragma unroll
                for (int r = 0; r < 4; ++r) { const float inv = 1.f / O[8][r];
#pragma unroll
                    for (int ct = 0; ct < 8; ++ct) *(LAS bf16*)(s_out + (4 * g4 + r) * 256 + (16 * ct + m16) * 2) = (bf16)f2bf(O[ct][r] * inv); } }
            LDS_WAIT(); asm volatile("" ::: "memory");
#pragma unroll
            for (int i = 0; i < 2; ++i) { const int n = lane + 64 * i; *(GAS v4u*)(QLAT + (size_t)rowq * 1024 + n * 8) = *(LAS v4u*)(s_out + n * 16); }
            LDS_WAIT(); asm volatile("" ::: "memory");
        }
    }
}
__device__ __forceinline__ void final_norm(Frame& F) {
    const int gw = F.vcu * NWAVES + F.wave, NGW = F.G * NWAVES, lane = (opaque((int)threadIdx.x) & 63);
    const pg8::ssq_t ssq = ssq_arr(F, 12); const float* g = ain(2);
    f32x4 gv[4];
#pragma unroll
    for (int j = 0; j < 4; ++j) gv[j] = ((const f32x4*)g)[lane + 64 * j];
    for (int m0 = gw; m0 < M; m0 += 4 * NGW) {
        unsigned long long q[4][4]; float r[4];
#pragma unroll
        for (int i = 0; i < 4; ++i) { const int m = m0 + i * NGW; const GAS unsigned long long* xi = (const GAS unsigned long long*)(wsb(F, WS_XB) + (size_t)m * D) + lane;
#pragma unroll
            for (int j = 0; j < 4; ++j) q[i][j] = xi[64 * j];
            r[i] = rsqrtf(pg8::sget(ssq, m) * (1.f / 1024.f) + EPSN); }
#pragma unroll
        for (int i = 0; i < 4; ++i) { const int m = m0 + i * NGW; GAS f32x4* xo = (GAS f32x4*)(aout() + (size_t)m * D) + lane;
#pragma unroll
            for (int j = 0; j < 4; ++j) { const unsigned a = (unsigned)q[i][j], b = (unsigned)(q[i][j] >> 32);
                f32x4 v = (f32x4){__uint_as_float(a << 16), __uint_as_float(a & 0xffff0000u), __uint_as_float(b << 16), __uint_as_float(b & 0xffff0000u)}; v = v * r[i] * gv[j]; xo[64 * j] = v; } }
    }
}

__global__ void __launch_bounds__(NWAVES * 64, 2) hybrid_fwd(Args args) {
    extern __shared__ __attribute__((aligned(16))) unsigned char lds[];
    Frame F;
    F.lds = (LAS unsigned char*)lds;
        F.wave = __builtin_amdgcn_readfirstlane((int)threadIdx.x >> 6);
    F.G = gridDim.x; { const int bx = blockIdx.x; F.vcu = (F.G % 8 == 0) ? (bx % 8) * (F.G / 8) + bx / 8 : bx; }
    F.ws = aws();
    ASSUME_GLOBAL(F.ws);
    for (int u = threadIdx.x; u < (LDS_BYTES - LDSCTL_OFF) / 4; u += NWAVES * 64) ((LAS unsigned*)(F.lds + LDSCTL_OFF))[u] = 0u;
    __syncthreads();
    if (!MK_PER_PHASE) (void)xcd_barrier_post((unsigned*)((gu32*)(F.ws + WS_CTL) + CW_BAR), (volatile LAS unsigned*)(F.lds + MISC_OFF) + 8);
#ifdef PROBE_PHASE
    unsigned long long probe_acc = 0ull, probe_t0 = 0ull;
#define PROBE_BEGIN(k) do { if ((k) == PROBE_PHASE) probe_t0 = __builtin_amdgcn_s_memrealtime(); } while (0)
#define PROBE_END(k) do { if ((k) == PROBE_PHASE) probe_acc += __builtin_amdgcn_s_memrealtime() - probe_t0; } while (0)
#else
#define PROBE_BEGIN(k) do {} while (0)
#define PROBE_END(k) do {} while (0)
#endif
#define IN(k) (aint(216) <= (k) && (k) < aint(220))
#define GRID_BAR(k) do { if (IN(k) && IN((k) + 1)) { XcdBarrier bar_; { unsigned char* bw_ = F.ws; asm volatile("" : "+s"(bw_)); bar_.bar = (unsigned*)((gu32*)(bw_ + WS_CTL) + CW_BAR); } bar_.x = xb_xcc_id(); bar_.st = (volatile LAS unsigned*)(F.lds + MISC_OFF) + 8; xcd_barrier(bar_); } } while (0)

    PROBE_BEGIN(7); if (IN(0)) { p0_prologue(F); GRID_BAR(0); } PROBE_END(7);

    for (int l = 0; l < 2; ++l) {
        const int pb = 1 + 7 * l;
#define WL(off) ((const bf16*)(F.ws + WS_W + (size_t)lq * W_LAYER + (off)))
        if (IN(pb + 0) && PH_ON(0)) { PROBE_BEGIN(0); int lq = l; asm volatile("" : "+s"(lq));
            pg8::Gemm g{wsb(F, WS_XB), WL(W_IN), M, 4096, 1024}; pg8::StaticOrder So; So.init(M, 4096, F.G, opaque_s((int)blockIdx.x));
            pg8::EpiG1 E{F.ws, lq, ain(6) + lq * 4, ain(7) + lq * 4};
            pg8::gemm_phase<pg8::EpiG1, pg8::StaticOrder, true, true>(F.lds + RING_OFF, g, So, E);
            GRID_BAR(pb + 0); PROBE_END(0);
        }
        if (IN(pb + 1) && PH_ON(1)) { PROBE_BEGIN(1); int lq = l; asm volatile("" : "+s"(lq));
            p2_norms(F, lq);
            pg8::Gemm g{wsb(F, WS_CQ), WL(W_Q2), M, 1536, 256}; pg8::StaticOrder So; So.init(M, 1536, F.G, opaque_s((int)blockIdx.x));
            pg8::EpiQ2 E{F.ws, lq};
            pg8::gemm_phase<pg8::EpiQ2, pg8::StaticOrder, true, true>(F.lds + RING_OFF, g, So, E);
            GRID_BAR(pb + 1); PROBE_END(1);
        }
        if (IN(pb + 2) && PH_ON(2)) { PROBE_BEGIN(2); int lq = l; asm volatile("" : "+s"(lq));
            if (F.vcu < 64) mlstm_unit(F, lq, F.vcu >> 2, F.vcu & 3);
            else if (F.vcu < 128) { const int u = F.vcu - 64; retention_unit(F, lq, u >> 2, u & 3); }
            dsa_phase(F, lq);
            GRID_BAR(pb + 2); PROBE_END(2);
        }
        if (IN(pb + 3) && PH_ON(3)) { PROBE_BEGIN(3); int lq = l; asm volatile("" : "+s"(lq));
            for (int br = 0; br < 3; ++br) {
                {
                    pg8::Gemm g{wsb(F, WS_XB), WL(W_G) + (size_t)br * 1024 * 1024, M, 1024, 1024}; pg8::StaticOrder So; So.init(M, 1024, F.G, opaque_s((int)blockIdx.x));
                    pg8::EpiGate E{F.ws, lq};
                    pg8::gemm_phase<pg8::EpiGate, pg8::StaticOrder, true, true>(F.lds + RING_OFF, g, So, E);
                }
                {
                    const bf16* A = wsb(F, br == 0 ? WS_MV : (br == 1 ? WS_QLAT : WS_RV));
                    const bf16* Bt = WL(br == 0 ? W_PM : (br == 1 ? W_AV : W_PR));
                    pg8::Gemm g{A, Bt, M, 1024, br == 1 ? 1024 : 512}; pg8::StaticOrder So; So.init(M, 1024, F.G, opaque_s((int)blockIdx.x));
                    pg8::EpiBr E{F.ws, br};
                    pg8::gemm_phase<pg8::EpiBr, pg8::StaticOrder, true, true>(F.lds + RING_OFF, g, So, E);
                }
            }
            GRID_BAR(pb + 3); PROBE_END(3);
        }
        if (IN(pb + 4) && PH_ON(4)) { PROBE_BEGIN(4); int lq = l; asm volatile("" : "+s"(lq));
            pg8::Gemm g{wsb(F, WS_Y), WL(W_OUT), M, 1024, 1024}; pg8::StaticOrder So; So.init(M, 1024, F.G, opaque_s((int)blockIdx.x));
            pg8::EpiRes E{F.ws, lq * 6 + 1};
            pg8::gemm_phase<pg8::EpiRes, pg8::StaticOrder, true, true>(F.lds + RING_OFF, g, So, E);
            GRID_BAR(pb + 4); PROBE_END(4);
        }
        if (IN(pb + 5) && PH_ON(5)) { PROBE_BEGIN(5); int lq = l; asm volatile("" : "+s"(lq));
            pg8::Gemm g{wsb(F, WS_XB), WL(W_GU), M, 5632, 1024}; pg8::StaticOrder So; So.init(M, 5632, F.G, opaque_s((int)blockIdx.x));
            pg8::EpiUp E{F.ws, lq};
            pg8::gemm_phase<pg8::EpiUp, pg8::StaticOrder, true, true>(F.lds + RING_OFF, g, So, E);
            GRID_BAR(pb + 5); PROBE_END(5);
        }
        if (IN(pb + 6) && PH_ON(6)) { PROBE_BEGIN(6); int lq = l; asm volatile("" : "+s"(lq));
            pg8::Gemm g{wsb(F, WS_HID), WL(W_DN), M, 1024, 2816}; pg8::StaticOrder So; So.init(M, 1024, F.G, opaque_s((int)blockIdx.x));
            pg8::EpiRes E{F.ws, lq == 0 ? 6 : 12};
            pg8::gemm_phase<pg8::EpiRes, pg8::StaticOrder, true, true>(F.lds + RING_OFF, g, So, E);
            GRID_BAR(pb + 6); PROBE_END(6);
        }
#undef WL
    }
    if (IN(15)) final_norm(F);
#ifdef PROBE_PHASE
    { const unsigned long long t1 = __builtin_amdgcn_s_memrealtime(); while (__builtin_amdgcn_s_memrealtime() - t1 < probe_acc) __builtin_amdgcn_s_sleep(8); }
#endif
#undef IN
#undef GRID_BAR
}

extern "C" void kernel_launch(void* const* d_in, const int* in_sizes, int n_in, void* d_out, int out_size, void* d_ws, size_t ws_size, hipStream_t stream) {
    static int grid = 0;
    if (grid == 0) {
        if (n_in != 25 || out_size != M * D || ws_size < WS_END) { fprintf(stderr, "kernel_launch: unexpected shapes / workspace (%d inputs, out %d, ws %zu)\n", n_in, out_size, ws_size); grid = -1; return; }
        int dev = 0, cus = 0, per_cu = 0;
        if (hipGetDevice(&dev) != hipSuccess || hipDeviceGetAttribute(&cus, hipDeviceAttributeMultiprocessorCount, dev) != hipSuccess) { grid = -1; return; }
        if (hipFuncSetAttribute((const void*)hybrid_fwd, hipFuncAttributeMaxDynamicSharedMemorySize, LDS_BYTES) != hipSuccess) { grid = -1; return; }
        if (hipOccupancyMaxActiveBlocksPerMultiprocessor(&per_cu, (const void*)hybrid_fwd, NWAVES * 64, LDS_BYTES) != hipSuccess || per_cu < 1) { fprintf(stderr, "kernel_launch: occupancy query says %d\n", per_cu); }
        (void)hipGetLastError();
        grid = cus;
    }
    if (grid < 0) return;
    if (hipMemsetAsync((char*)d_ws + WS_CTL, 0, CTL_ZERO_BYTES, stream) != hipSuccess) return;
    Args a{};
    for (int i = 0; i < 25; ++i) a.in[i] = (const float*)d_in[i];
    a.out = (float*)d_out; a.ws = (unsigned char*)d_ws;
#if MK_PER_PHASE
    for (int p = 0; p < N_PHASES; ++p) { a.ph_lo = p; a.ph_hi = p + 1; hipLaunchKernelGGL(hybrid_fwd, dim3(grid), dim3(NWAVES * 64), LDS_BYTES, stream, a); }
#else
    a.ph_lo = 0; a.ph_hi = N_PHASES;
    hipLaunchKernelGGL(hybrid_fwd, dim3(grid), dim3(NWAVES * 64), LDS_BYTES, stream, a);
#endif
}
```
